# Optimizing an MI355X kernel written in HIP

```python
import math
import jax
import jax.numpy as jnp
from jax import lax
import numpy as np

D_MODEL = 1024
BATCH = 2
SEQ = 8192
DEPTH = 2

SSM_HEADS = 16
SSM_HEAD_DIM = 64
SSM_INNER = SSM_HEADS * SSM_HEAD_DIM
SSM_GROUPS = 2
SSM_STATE = 128
SSM_CONV = 4
SSM_CHUNK = 128
SSM_CONV_DIM = SSM_INNER + 2 * SSM_GROUPS * SSM_STATE

GMLP_GROUPS = 8
GMLP_GROUP_DIM = 128
GMLP_INNER = GMLP_GROUPS * GMLP_GROUP_DIM
GMLP_CHUNK = 128

MIX_WIDTH = SSM_INNER + GMLP_INNER
IN_EVEN = SSM_INNER + SSM_CONV_DIM + SSM_HEADS + 2 * GMLP_INNER

ATTN_HEADS = 16
ATTN_KV_HEADS = 2
ATTN_HEAD_DIM = 64
ATTN_Q_PER_KV = ATTN_HEADS // ATTN_KV_HEADS
WINDOW = 128
ATTN_BLOCK = 128
QKV_DIM = (ATTN_HEADS + 2 * ATTN_KV_HEADS) * ATTN_HEAD_DIM
REL_BUCKETS = 32
REL_MAX_DIST = 128

FFN_HIDDEN = -(-8 * D_MODEL // (3 * 256)) * 256

N_EVEN = (DEPTH + 1) // 2
N_ODD = DEPTH // 2
EPS = 1e-6
NEG_INF = -1e30

kernel_name = "hybrid_ssd_gmlp_swa_adaln_trunk"


def rms_norm(x, w):
    xf = x.astype(jnp.float32)
    y = xf * lax.rsqrt(jnp.mean(xf * xf, axis=-1, keepdims=True) + EPS)
    return (y * w.astype(jnp.float32)).astype(x.dtype)


def layer_norm(x, w, b):
    xf = x.astype(jnp.float32)
    mu = jnp.mean(xf, axis=-1, keepdims=True)
    var = jnp.mean(jnp.square(xf - mu), axis=-1, keepdims=True)
    y = (xf - mu) * lax.rsqrt(var + EPS)
    return (y * w.astype(jnp.float32) + b.astype(jnp.float32)).astype(x.dtype)


def modulate(h, shift, scale):
    return h * (1 + scale[:, None, :]) + shift[:, None, :]


def causal_dwconv(x, w, b):
    out = lax.conv_general_dilated(
        x, w[:, None, :].astype(x.dtype), window_strides=(1,),
        padding=[(SSM_CONV - 1, 0)], dimension_numbers=('NWC', 'WIO', 'NWC'),
        feature_group_count=x.shape[-1])
    return out + b


def ssd_chunked(x, dt, a, bmat, cmat):
    f32 = jnp.float32
    bsz, seq, nh, hd = x.shape
    ng, ns = bmat.shape[-2:]
    hpg = nh // ng
    nc = seq // SSM_CHUNK
    L = SSM_CHUNK
    xd = (x.astype(f32) * dt[..., None]).reshape(bsz, nc, L, ng, hpg, hd)
    la = jnp.moveaxis((dt * a).reshape(bsz, nc, L, ng, hpg), 2, -1)
    la_cum = jnp.cumsum(la, axis=-1)
    bc = bmat.astype(f32).reshape(bsz, nc, L, ng, ns)
    cc = cmat.astype(f32).reshape(bsz, nc, L, ng, ns)
    causal = jnp.tril(jnp.ones((L, L), dtype=bool))
    seg = la_cum[..., :, None] - la_cum[..., None, :]
    decay = jnp.where(causal, jnp.exp(jnp.where(causal, seg, 0.0)), 0.0)
    cb = jnp.einsum('bclgn,bcsgn->bcgls', cc, bc)
    y_diag = jnp.einsum('bcgjls,bcsgjp->bclgjp', cb[:, :, :, None] * decay, xd)
    decay_to_end = jnp.exp(la_cum[..., -1:] - la_cum)
    states = jnp.einsum('bcsgn,bcgjs,bcsgjp->bcgjpn', bc, decay_to_end, xd)
    chunk_decay = jnp.exp(la_cum[..., -1])

    def step(carry, inp):
        st, dec = inp
        return carry * dec[..., None, None] + st, carry

    init = jnp.zeros((bsz, ng, hpg, hd, ns), f32)
    _, prev = lax.scan(step, init, (jnp.moveaxis(states, 1, 0), jnp.moveaxis(chunk_decay, 1, 0)))
    prev = jnp.moveaxis(prev, 0, 1)
    y_off = jnp.einsum('bclgn,bcgjpn,bcgjl->bclgjp', cc, prev, jnp.exp(la_cum))
    return (y_diag + y_off).reshape(bsz, seq, nh, hd)


def ssd_branch(z, xbc, dt_raw, conv_w, conv_b, dt_bias, a_log, d_skip, norm_w):
    f32 = jnp.float32
    bsz, seq, _ = z.shape
    xbc = jax.nn.silu(causal_dwconv(xbc, conv_w, conv_b))
    xs, bm, cm = jnp.split(xbc, [SSM_INNER, SSM_INNER + SSM_GROUPS * SSM_STATE], axis=-1)
    xs = xs.reshape(bsz, seq, SSM_HEADS, SSM_HEAD_DIM)
    bm = bm.reshape(bsz, seq, SSM_GROUPS, SSM_STATE)
    cm = cm.reshape(bsz, seq, SSM_GROUPS, SSM_STATE)
    dt = jax.nn.softplus(dt_raw.astype(f32) + dt_bias.astype(f32))
    a = -jnp.exp(a_log.astype(f32))
    y = ssd_chunked(xs, dt, a, bm, cm) + d_skip.astype(f32)[:, None] * xs.astype(f32)
    y = y.reshape(bsz, seq, SSM_INNER) * jax.nn.silu(z.astype(f32))
    y = y.reshape(bsz, seq, SSM_GROUPS, SSM_INNER // SSM_GROUPS)
    y = y * lax.rsqrt(jnp.mean(y * y, axis=-1, keepdims=True) + EPS)
    return (y.reshape(bsz, seq, SSM_INNER) * norm_w.astype(f32)).astype(z.dtype)


def spatial_gating_branch(u, v, ln_w, ln_b, w_s, b_s):
    bsz, seq, _ = u.shape
    nc = seq // GMLP_CHUNK
    u = jax.nn.gelu(u, approximate=False)
    v = layer_norm(jax.nn.gelu(v, approximate=False), ln_w, ln_b)
    v = v.reshape(bsz, nc, GMLP_CHUNK, GMLP_GROUPS, GMLP_GROUP_DIM)
    w = w_s * jnp.tril(jnp.ones((GMLP_CHUNK, GMLP_CHUNK), w_s.dtype))
    sv = jnp.einsum('gts,bcsgd->bctgd', w, v) + b_s.T[None, None, :, :, None]
    return u * sv.reshape(bsz, seq, GMLP_INNER)


def even_mixer(h, in_w, conv_w, conv_b, dt_bias, a_log, d_skip, ssm_norm_w,
               ln_w, ln_b, w_s, b_s, out_w):
    proj = h @ in_w
    o1 = SSM_INNER
    o2 = o1 + SSM_CONV_DIM
    o3 = o2 + SSM_HEADS
    o4 = o3 + GMLP_INNER
    z, xbc, dt_raw, u, v = jnp.split(proj, [o1, o2, o3, o4], axis=-1)
    ya = ssd_branch(z, xbc, dt_raw, conv_w, conv_b, dt_bias, a_log, d_skip, ssm_norm_w)
    yb = spatial_gating_branch(u, v, ln_w, ln_b, w_s, b_s)
    return jnp.concatenate([ya, yb], axis=-1) @ out_w


def t5_relative_bias(table):
    qi = jnp.arange(ATTN_BLOCK)[:, None]
    sj = jnp.arange(2 * ATTN_BLOCK)[None, :]
    dist = jnp.maximum(qi + ATTN_BLOCK - sj, 0)
    max_exact = REL_BUCKETS // 2
    log_ratio = (jnp.log(jnp.maximum(dist, 1).astype(jnp.float32) / max_exact)
                 / math.log(REL_MAX_DIST / max_exact))
    large = max_exact + (log_ratio * (REL_BUCKETS - max_exact)).astype(jnp.int32)
    bucket = jnp.where(dist < max_exact, dist, jnp.minimum(large, REL_BUCKETS - 1))
    bias = table[bucket]
    return jnp.transpose(bias, (2, 0, 1)).reshape(
        ATTN_KV_HEADS, ATTN_Q_PER_KV, ATTN_BLOCK, 2 * ATTN_BLOCK)


def window_attention(h, w_qkv, b_qkv, w_o, b_o, sinks, rel_table):
    f32 = jnp.float32
    bsz, seq, _ = h.shape
    nb = seq // ATTN_BLOCK
    qkv = h @ w_qkv + b_qkv
    q, k, v = jnp.split(qkv, [ATTN_HEADS * ATTN_HEAD_DIM,
                              (ATTN_HEADS + ATTN_KV_HEADS) * ATTN_HEAD_DIM], axis=-1)
    q = q.reshape(bsz, nb, ATTN_BLOCK, ATTN_KV_HEADS, ATTN_Q_PER_KV, ATTN_HEAD_DIM)

    def band(t):
        t = t.reshape(bsz, nb, ATTN_BLOCK, ATTN_KV_HEADS, ATTN_HEAD_DIM)
        prev = jnp.pad(t, ((0, 0), (1, 0), (0, 0), (0, 0), (0, 0)))[:, :-1]
        return jnp.concatenate([prev, t], axis=2)

    kb, vb = band(k), band(v)
    scale = ATTN_HEAD_DIM ** -0.5
    logits = jnp.einsum('bnqkgd,bnskd->bnkgqs', q.astype(f32), kb.astype(f32)) * scale
    logits = logits + t5_relative_bias(rel_table).astype(f32)
    qi = jnp.arange(ATTN_BLOCK)[:, None]
    sj = jnp.arange(2 * ATTN_BLOCK)[None, :]
    rel = qi + ATTN_BLOCK - sj
    in_window = (rel >= 0) & (rel < WINDOW)
    key_pos = jnp.arange(nb)[:, None, None] * ATTN_BLOCK - ATTN_BLOCK + sj[None]
    mask = in_window[None] & (key_pos >= 0)
    logits = jnp.where(mask[None, :, None, None], logits, NEG_INF)
    sink = jnp.broadcast_to(
        sinks.astype(f32).reshape(ATTN_KV_HEADS, ATTN_Q_PER_KV)[None, None, :, :, None, None],
        logits.shape[:-1] + (1,))
    probs = jax.nn.softmax(jnp.concatenate([logits, sink], axis=-1), axis=-1)[..., :-1]
    out = jnp.einsum('bnkgqs,bnskd->bnqkgd', probs.astype(vb.dtype), vb)
    return out.reshape(bsz, seq, ATTN_HEADS * ATTN_HEAD_DIM) @ w_o + b_o


def swiglu(h, w_gate, w_up, w_down):
    return (jax.nn.silu(h @ w_gate) * (h @ w_up)) @ w_down


def setup_inputs(seed: int = 0) -> dict:
    key = jax.random.key(seed)
    ks = iter(jax.random.split(key, 40))
    nrm = lambda shape, s: jax.random.normal(next(ks), shape, jnp.float32) * s
    ones_n = lambda shape: 1.0 + nrm(shape, 0.02)
    D = D_MODEL
    dt0 = jnp.exp(jax.random.uniform(next(ks), (N_EVEN, SSM_HEADS), jnp.float32,
                                     math.log(1e-3), math.log(1e-1)))
    return {
        "x": nrm((BATCH, SEQ, D), 1.0),
        "c": nrm((BATCH, D), 1.0),
        "ada_w": nrm((DEPTH, D, 6 * D), 0.5 * D ** -0.5),
        "ada_b": nrm((DEPTH, 6 * D), 0.02),
        "norm_mix_w": ones_n((DEPTH, D)),
        "norm_ffn_w": ones_n((DEPTH, D)),
        "in_w_even": nrm((N_EVEN, D, IN_EVEN), D ** -0.5),
        "conv_w": nrm((N_EVEN, SSM_CONV, SSM_CONV_DIM), SSM_CONV ** -0.5),
        "conv_b": nrm((N_EVEN, SSM_CONV_DIM), 0.02),
        "dt_bias": dt0 + jnp.log(-jnp.expm1(-dt0)),
        "a_log": jnp.log(jax.random.uniform(next(ks), (N_EVEN, SSM_HEADS), jnp.float32, 1.0, 16.0)),
        "d_skip": 1.0 + nrm((N_EVEN, SSM_HEADS), 0.1),
        "ssm_norm_w": ones_n((N_EVEN, SSM_INNER)),
        "gmlp_ln_w": ones_n((N_EVEN, GMLP_INNER)),
        "gmlp_ln_b": nrm((N_EVEN, GMLP_INNER), 0.02),
        "gmlp_ws": nrm((N_EVEN, GMLP_GROUPS, GMLP_CHUNK, GMLP_CHUNK), GMLP_CHUNK ** -0.5),
        "gmlp_bs": 1.0 + nrm((N_EVEN, GMLP_GROUPS, GMLP_CHUNK), 0.02),
        "out_w_even": nrm((N_EVEN, MIX_WIDTH, D), MIX_WIDTH ** -0.5),
        "qkv_w": nrm((N_ODD, D, QKV_DIM), D ** -0.5),
        "qkv_b": nrm((N_ODD, QKV_DIM), 0.02),
        "o_w": nrm((N_ODD, ATTN_HEADS * ATTN_HEAD_DIM, D), (ATTN_HEADS * ATTN_HEAD_DIM) ** -0.5),
        "o_b": nrm((N_ODD, D), 0.02),
        "sinks": nrm((N_ODD, ATTN_HEADS), 1.0),
        "rel_table": nrm((REL_BUCKETS, ATTN_HEADS), 0.5),
        "ffn_gate_w": nrm((DEPTH, D, FFN_HIDDEN), D ** -0.5),
        "ffn_up_w": nrm((DEPTH, D, FFN_HIDDEN), D ** -0.5),
        "ffn_down_w": nrm((DEPTH, FFN_HIDDEN, D), FFN_HIDDEN ** -0.5),
        "final_norm_w": ones_n((D,)),
    }


def reference(x, c, ada_w, ada_b, norm_mix_w, norm_ffn_w, in_w_even, conv_w, conv_b,
              dt_bias, a_log, d_skip, ssm_norm_w, gmlp_ln_w, gmlp_ln_b, gmlp_ws, gmlp_bs,
              out_w_even, qkv_w, qkv_b, o_w, o_b, sinks, rel_table,
              ffn_gate_w, ffn_up_w, ffn_down_w, final_norm_w):
    cond = jax.nn.silu(c)
    for layer in range(DEPTH):
        mod = cond @ ada_w[layer] + ada_b[layer]
        sh1, sc1, g1, sh2, sc2, g2 = jnp.split(mod, 6, axis=-1)
        h = modulate(rms_norm(x, norm_mix_w[layer]), sh1, sc1)
        i = layer // 2
        if layer % 2 == 0:
            mix = even_mixer(h, in_w_even[i], conv_w[i], conv_b[i], dt_bias[i], a_log[i],
                             d_skip[i], ssm_norm_w[i], gmlp_ln_w[i], gmlp_ln_b[i],
                             gmlp_ws[i], gmlp_bs[i], out_w_even[i])
        else:
            mix = window_attention(h, qkv_w[i], qkv_b[i], o_w[i], o_b[i], sinks[i], rel_table)
        x = x + g1[:, None, :] * mix
        h = modulate(rms_norm(x, norm_ffn_w[layer]), sh2, sc2)
        x = x + g2[:, None, :] * swiglu(h, ffn_gate_w[layer], ffn_up_w[layer], ffn_down_w[layer])
    return rms_norm(x, final_norm_w)
```

```cpp
#include <hip/hip_runtime.h>
#include <cstdio>
#include <cstdint>

#ifndef MK_ONE_LAUNCH
#define MK_ONE_LAUNCH 0
#endif
#ifndef MK_NAIVE
#define MK_NAIVE 1
#endif

#define GAS __attribute__((address_space(1)))
#define LAS __attribute__((address_space(3)))
typedef unsigned short bf16;
typedef unsigned v4u __attribute__((ext_vector_type(4)));
typedef unsigned v2u __attribute__((ext_vector_type(2)));
typedef float f32x4 __attribute__((ext_vector_type(4)));
typedef float f32x2 __attribute__((ext_vector_type(2)));
typedef float f32x16 __attribute__((ext_vector_type(16)));
typedef short bf16x8 __attribute__((ext_vector_type(8)));
typedef GAS unsigned gu32;

constexpr int BATCH = 2, SEQ = 8192, DM = 1024, MTOK = BATCH * SEQ;
constexpr int IN_EVEN = 4624, NPROJ = 4608;
constexpr int PJ_Z = 0, PJ_U = 1024, PJ_X = 2048, PJ_B = 3072, PJ_C = 3328, PJ_V = 3584;
constexpr int FFN = 2816, NGU = 5632, QKVD = 1280;
constexpr int NCH = 64, CHUNK = 128, NHEAD = 16, HDIM = 64, NSTATE = 128, CONVD = 1536;
constexpr float EPS = 1e-6f;

constexpr size_t MiB = 1u << 20, KiB = 1024;
constexpr size_t WS_CTL = 0, CTL_ZERO_BYTES = 1 * MiB;
constexpr size_t WS_MOD = 1 * MiB;
constexpr size_t WS_CD = 1 * MiB + 128 * KiB;
constexpr size_t WS_VST = 1 * MiB + 256 * KiB;
constexpr size_t WS_DT = 2 * MiB;
constexpr size_t WS_LAC = 3 * MiB;
constexpr size_t WS_HALO = 4 * MiB;
constexpr size_t WS_WST = 5 * MiB + 512 * KiB;
constexpr size_t WS_WIN = 6 * MiB;
constexpr size_t WS_WOUT = 15 * MiB;
constexpr size_t WS_WQKV = 19 * MiB;
constexpr size_t WS_WO = 21 * MiB + 512 * KiB;
constexpr size_t WS_WGU = 23 * MiB + 512 * KiB;
constexpr size_t WS_WD = 45 * MiB + 512 * KiB;
constexpr size_t WS_XN = 57 * MiB;
constexpr size_t WS_ST = WS_XN;
constexpr size_t WS_PROJ = 89 * MiB;
constexpr size_t WS_H = WS_PROJ;
constexpr size_t WS_QKV = WS_PROJ;
constexpr size_t WS_AO = WS_PROJ + 40 * MiB;
constexpr size_t WS_CBG = 233 * MiB;
constexpr size_t WS_END = 249 * MiB;
constexpr int CW_BAR = 4096;
constexpr int XCD_BAR_WORDS_C = 3456;

#define RLX_AGENT __ATOMIC_RELAXED, __HIP_MEMORY_SCOPE_AGENT
#define LDS_WAIT() asm volatile("s_waitcnt lgkmcnt(0)" ::: "memory")
#define VM_WAIT() asm volatile("s_waitcnt vmcnt(0)" ::: "memory")
__host__ __device__ __forceinline__ unsigned f2bf(float f) { unsigned u = __builtin_bit_cast(unsigned, f); return (u + 0x7fffu + ((u >> 16) & 1u)) >> 16; }
__host__ __device__ __forceinline__ float bf2f(unsigned short h) { return __builtin_bit_cast(float, (unsigned)h << 16); }
__device__ __forceinline__ unsigned pk2(float lo, float hi) { return f2bf(lo) | (f2bf(hi) << 16); }
__device__ __forceinline__ float silu_f(float x) { return x / (1.0f + __expf(-x)); }
__device__ __forceinline__ float wave_sum(float v) {
#pragma unroll
    for (int o = 1; o < 64; o <<= 1) v += __shfl_xor(v, o);
    return v;
}

namespace pg8 {
#define PG8_LAS __attribute__((address_space(3)))
typedef unsigned short bf16_t;
typedef unsigned u32x4 __attribute__((ext_vector_type(4)));
constexpr int BM = 256, BK = 64, HALF = 128, HTB = HALF * BK * 2, STAGE_BYTES = 8 * HTB, NXCD = 8, WGM = 8;

__host__ __device__ __forceinline__ int lds_byte(int r, int c) { const int st = (r >> 4) * 2 + (c >> 5), rr = r & 15, cc = c & 31, ob = rr * 64 + cc * 2; return st * 1024 + (ob ^ (((ob >> 9) & 1) << 5)); }
__host__ __device__ __forceinline__ void stage_rc(int b, int& R, int& C) { const int st = b / 1024, sb = b % 1024, swz = sb ^ (((sb >> 9) & 1) << 5); R = (st >> 1) * 16 + swz / 64; C = (st & 1) * 32 + (swz % 64) / 2; }
__host__ __device__ __forceinline__ int perm32(int rho) { const int n = rho >> 4, i = rho & 15; return 8 * (i >> 2) + 4 * n + (i & 3); }

struct Unit { int pm, pn; };
struct Gemm { const bf16_t* A; const bf16_t* Bt; int M, N, K, lda; };

struct StaticOrder {
    int nM, nN, nwg, G, c;
    __host__ __device__ void init(int M, int N, int G_, int c_) { nM = M / BM; nN = N / BM; nwg = nM * nN; G = G_; c = c_; }
    __host__ __device__ bool next(int i, Unit& u) const {
        const long L = (long)i * G + c; if (L >= nwg) return false;
        int wgid = (int)L; { const int q = nwg / NXCD, r = nwg % NXCD, xcd = wgid % NXCD, off = wgid / NXCD; wgid = (xcd < r ? xcd * (q + 1) : r * (q + 1) + (xcd - r) * q) + off; }
        const int nig = WGM * nN, gid = wgid / nig, fm = gid * WGM, gsz = (nM - fm) < WGM ? (nM - fm) : WGM;
        u.pm = fm + ((wgid % nig) % gsz); u.pn = (wgid % nig) / gsz; return true;
    }
    __device__ __forceinline__ void a_ready(const Unit&) const {}
    __device__ __forceinline__ void done(const Unit&) const {}
};

__device__ __forceinline__ unsigned cvt_pk_bf16(float lo, float hi) { unsigned r; asm volatile("v_cvt_pk_bf16_f32 %0, %1, %2" : "=v"(r) : "v"(lo), "v"(hi)); return r; }
__device__ __forceinline__ f32x2 gelu_pk(f32x2 v) {
    const f32x2 av = __builtin_elementwise_abs(v), d = av * 0.2316418882f + 1.0f;
    f32x2 t; t.x = __builtin_amdgcn_rcpf(d.x); t.y = __builtin_amdgcn_rcpf(d.y);
    f32x2 q = t * 0.5307027145f + (-0.7265760135f); q = q * t + 0.7107068705f; q = q * t + (-0.142248368f); q = q * t + 0.127414796f; q = q * t;
    const f32x2 s = (v * v) * (-0.72134752044f);
    f32x2 e; e.x = __builtin_amdgcn_exp2f(s.x); e.y = __builtin_amdgcn_exp2f(s.y);
    const f32x2 m = v * (q * e), r = v - m;
    f32x2 o; o.x = v.x < 0.f ? m.x : r.x; o.y = v.y < 0.f ? m.y : r.y; return o;
}
__device__ __forceinline__ float silu1(float x) { return x * __builtin_amdgcn_rcpf(1.0f + __builtin_amdgcn_exp2f(-1.4426950408889634f * x)); }
__device__ __forceinline__ f32x4 silu4(f32x4 v) { f32x4 o; o[0] = silu1(v[0]); o[1] = silu1(v[1]); o[2] = silu1(v[2]); o[3] = silu1(v[3]); return o; }
__device__ __forceinline__ f32x4 gelu4(f32x4 v) { f32x2 a = gelu_pk((f32x2){v[0], v[1]}), b = gelu_pk((f32x2){v[2], v[3]}); return (f32x4){a.x, a.y, b.x, b.y}; }

struct EpiBf16 {
    static constexpr bool PERM = true, AFTER_DRAIN = false;
    bf16_t* O; int ldc; const float* bias;
    __device__ __forceinline__ void operator()(const f32x4 (&acc)[2][2][4][2], const Unit& u, int wr, int wc, int fr, int fq) const {
        const int row0 = u.pm * BM + wr * 64 + fr; const int col0 = u.pn * BM + wc * 32 + 8 * fq;
        f32x4 bv[2][2];
#pragma unroll
        for (int bj = 0; bj < 2; ++bj)
#pragma unroll
            for (int n = 0; n < 2; ++n) bv[bj][n] = bias ? *(const f32x4*)(bias + col0 + bj * HALF + 4 * n) : (f32x4){0.f, 0.f, 0.f, 0.f};
#pragma unroll
        for (int ai = 0; ai < 2; ++ai)
#pragma unroll
            for (int m = 0; m < 4; ++m) { bf16_t* rowp = O + (size_t)(row0 + ai * HALF + m * 16) * ldc + col0;
#pragma unroll
                for (int bj = 0; bj < 2; ++bj) { f32x4 v0 = acc[ai][bj][m][0] + bv[bj][0], v1 = acc[ai][bj][m][1] + bv[bj][1];
                    u32x4 w; w.x = cvt_pk_bf16(v0[0], v0[1]); w.y = cvt_pk_bf16(v0[2], v0[3]); w.z = cvt_pk_bf16(v1[0], v1[1]); w.w = cvt_pk_bf16(v1[2], v1[3]);
                    *(u32x4*)(rowp + bj * HALF) = w; } }
    }
};
struct EpiProj {
    static constexpr bool PERM = true, AFTER_DRAIN = false;
    bf16_t* O; bf16_t* halo;
    __device__ __forceinline__ void operator()(const f32x4 (&acc)[2][2][4][2], const Unit& u, int wr, int wc, int fr, int fq) const {
        const int row0 = u.pm * BM + wr * 64 + fr; const int col0 = u.pn * BM + wc * 32 + 8 * fq;
        const int act = (u.pn < 4) ? 1 : ((u.pn < 8 || u.pn >= 14) ? 2 : 0);
#pragma unroll
        for (int ai = 0; ai < 2; ++ai)
#pragma unroll
            for (int m = 0; m < 4; ++m) { const int row = row0 + ai * HALF + m * 16; bf16_t* rowp = O + (size_t)row * NPROJ + col0;
#pragma unroll
                for (int bj = 0; bj < 2; ++bj) { f32x4 v0 = acc[ai][bj][m][0], v1 = acc[ai][bj][m][1];
                    if (act == 1) { v0 = silu4(v0); v1 = silu4(v1); } else if (act == 2) { v0 = gelu4(v0); v1 = gelu4(v1); }
                    u32x4 w; w.x = cvt_pk_bf16(v0[0], v0[1]); w.y = cvt_pk_bf16(v0[2], v0[3]); w.z = cvt_pk_bf16(v1[0], v1[1]); w.w = cvt_pk_bf16(v1[2], v1[3]);
                    *(u32x4*)(rowp + bj * HALF) = w;
                    if (act == 0) { const int tl = row & 127; const int cn = ((row & (SEQ - 1)) >> 7) + 1;
                        if (tl >= 125 && cn < NCH) { const int b = row >> 13; const int ch = (u.pn - 8) * BM + wc * 32 + 8 * fq + bj * HALF;
                            *(u32x4*)(halo + ((size_t)((b * NCH + cn) * 3 + (tl - 125))) * CONVD + ch) = w; } } } }
    }
};
struct EpiRes {
    static constexpr bool PERM = false, AFTER_DRAIN = false;
    const float* base; float* out; const float* bias; const float* gate;
    __device__ __forceinline__ void operator()(const f32x4 (&acc)[2][2][4][2], const Unit& u, int wr, int wc, int fr, int fq) const {
        const int row0 = u.pm * BM + wr * 64 + fr, col0 = u.pn * BM + wc * 32 + 4 * fq; const int b = u.pm >> 5;
        f32x4 gv[2][2], bv[2][2];
#pragma unroll
        for (int bj = 0; bj < 2; ++bj)
#pragma unroll
            for (int n = 0; n < 2; ++n) { gv[bj][n] = *(const f32x4*)(gate + (size_t)b * 6144 + col0 + bj * HALF + n * 16);
                bv[bj][n] = bias ? *(const f32x4*)(bias + col0 + bj * HALF + n * 16) : (f32x4){0.f, 0.f, 0.f, 0.f}; }
#pragma unroll
        for (int ai = 0; ai < 2; ++ai)
#pragma unroll
            for (int m = 0; m < 4; ++m) { const size_t off = (size_t)(row0 + ai * HALF + m * 16) * DM + col0;
#pragma unroll
                for (int bj = 0; bj < 2; ++bj)
#pragma unroll
                    for (int n = 0; n < 2; ++n) { const f32x4 bs = *(const f32x4*)(base + off + bj * HALF + n * 16);
                        *(f32x4*)(out + off + bj * HALF + n * 16) = bs + gv[bj][n] * (acc[ai][bj][m][n] + bv[bj][n]); }
                if (m & 1) asm volatile("" ::: "memory"); }
    }
};
struct EpiSwiGLU {
    static constexpr bool PERM = true, AFTER_DRAIN = false;
    bf16_t* H;
    __device__ __forceinline__ void operator()(const f32x4 (&acc)[2][2][4][2], const Unit& u, int wr, int wc, int fr, int fq) const {
        const int row0 = u.pm * BM + wr * 64 + fr; const int col0 = u.pn * HALF + wc * 32 + 8 * fq;
#pragma unroll
        for (int ai = 0; ai < 2; ++ai)
#pragma unroll
            for (int m = 0; m < 4; ++m) { bf16_t* rowp = H + (size_t)(row0 + ai * HALF + m * 16) * FFN + col0;
                const f32x4 h0 = silu4(acc[ai][0][m][0]) * acc[ai][1][m][0], h1 = silu4(acc[ai][0][m][1]) * acc[ai][1][m][1];
                u32x4 w; w.x = cvt_pk_bf16(h0[0], h0[1]); w.y = cvt_pk_bf16(h0[2], h0[3]); w.z = cvt_pk_bf16(h1[0], h1[1]); w.w = cvt_pk_bf16(h1[2], h1[3]);
                *(u32x4*)rowp = w; }
    }
};

template <class Epi, class Sched, bool ALIGN_EPI = false, bool SP2 = false>
__device__ __forceinline__ void gemm_phase(PG8_LAS unsigned char* lds, const Gemm g, const Sched& S, const Epi& E) {
    const int tid = threadIdx.x, wid = __builtin_amdgcn_readfirstlane(tid >> 6), lane = tid & 63, wr = wid >> 2, wc = wid & 3, fr = lane & 15, fq = lane >> 4;
    const int K = g.K, nt = K / BK, lda = g.lda;
    unsigned voffA[2], voffB[2];
#pragma unroll
    for (int i = 0; i < 2; ++i) { int R, C; stage_rc(tid * 16 + i * 8192, R, C); const int Rb = Epi::PERM ? ((R & ~31) + perm32(R & 31)) : R;
        voffA[i] = (unsigned)(R * lda + C) * 2u; voffB[i] = (unsigned)(Rb * K + C) * 2u; }
    const size_t kstep = (size_t)(BK * 2);
    const size_t hstepA = (size_t)HALF * lda * 2, hstepB = (size_t)HALF * K * 2;
    const size_t tstepA = 2 * hstepA, tstepB = 2 * hstepB;
    const unsigned ldsw = (unsigned)wid * 1024u;
    const int aoff = lds_byte(wr * 64 + fr, fq * 8), boff = lds_byte(wc * 32 + fr, fq * 8);
#define PG8_SA(b, h) (((b) * 2 + (h)) * HTB)
#define PG8_SB(b, h) ((4 + (b) * 2 + (h)) * HTB)
#define PG8_STAGE(bufoff, gbase, voff) do { _Pragma("unroll") for (int _i = 0; _i < 2; ++_i) \
        __builtin_amdgcn_global_load_lds((const unsigned*)((const char*)(gbase) + (voff)[_i]), (PG8_LAS unsigned*)(lds + (bufoff) + ldsw + _i * 8192), 16, 0, 0); } while (0)
#define PG8_LDA(dst, b, h) do { _Pragma("unroll") for (int m = 0; m < 4; ++m) _Pragma("unroll") for (int k = 0; k < 2; ++k) dst[m][k] = *(const PG8_LAS bf16x8*)(lds + PG8_SA(b, h) + aoff + m * 2048 + k * 1024); } while (0)
#define PG8_LDB(dst, b, h) do { _Pragma("unroll") for (int n = 0; n < 2; ++n) _Pragma("unroll") for (int k = 0; k < 2; ++k) dst[n][k] = *(const PG8_LAS bf16x8*)(lds + PG8_SB(b, h) + boff + n * 2048 + k * 1024); } while (0)
#define PG8_MMA(ai, bj, At, Bt) do { __builtin_amdgcn_s_setprio(1); _Pragma("unroll") for (int m = 0; m < 4; ++m) _Pragma("unroll") for (int n = 0; n < 2; ++n) _Pragma("unroll") for (int k = 0; k < 2; ++k) \
        acc[ai][bj][m][n] = __builtin_amdgcn_mfma_f32_16x16x32_bf16(Bt[n][k], At[m][k], acc[ai][bj][m][n], 0, 0, 0); __builtin_amdgcn_s_setprio(0); } while (0)
#define PG8_WAIT_V(n) asm volatile("s_waitcnt vmcnt(" #n ")" ::: "memory")
#define PG8_WAIT_L(n) asm volatile("s_waitcnt lgkmcnt(" #n ")" ::: "memory")
#define PG8_BAR __builtin_amdgcn_s_barrier()
#define PG8_SCHED __builtin_amdgcn_sched_barrier(0)
    Unit cur, nxt; int ui = 0;
    if (!S.next(0, cur)) return;
    f32x4 acc[2][2][4][2];
#pragma unroll
    for (int a = 0; a < 2; ++a)
#pragma unroll
        for (int b = 0; b < 2; ++b)
#pragma unroll
            for (int m = 0; m < 4; ++m)
#pragma unroll
                for (int n = 0; n < 2; ++n) acc[a][b][m][n] = (f32x4){0.f, 0.f, 0.f, 0.f};
    bf16x8 At[4][2], B0[2][2], B1[2][2];
    const char* cA = (const char*)g.A + (size_t)cur.pm * tstepA; const char* cB = (const char*)g.Bt + (size_t)cur.pn * tstepB;
    S.a_ready(cur);
    if constexpr (SP2) {
        PG8_STAGE(PG8_SB(0, 0), cB, voffB); PG8_STAGE(PG8_SB(0, 1), cB + hstepB, voffB); PG8_STAGE(PG8_SA(0, 0), cA, voffA); PG8_STAGE(PG8_SA(0, 1), cA + hstepA, voffA);
        if (wr == 1) PG8_BAR;
        PG8_WAIT_V(2); PG8_BAR;
        PG8_STAGE(PG8_SB(1, 0), cB + kstep, voffB); PG8_STAGE(PG8_SA(1, 0), cA + kstep, voffA); PG8_STAGE(PG8_SB(1, 1), cB + hstepB + kstep, voffB);
        PG8_WAIT_V(6); PG8_BAR;
    } else {
        PG8_STAGE(PG8_SB(0, 0), cB, voffB); PG8_STAGE(PG8_SA(0, 0), cA, voffA); PG8_STAGE(PG8_SB(0, 1), cB + hstepB, voffB); PG8_STAGE(PG8_SA(0, 1), cA + hstepA, voffA);
        if (wr == 1) PG8_BAR;
        PG8_WAIT_V(4); PG8_BAR;
        PG8_STAGE(PG8_SB(1, 0), cB + kstep, voffB); PG8_STAGE(PG8_SA(1, 0), cA + kstep, voffA); PG8_STAGE(PG8_SB(1, 1), cB + hstepB + kstep, voffB);
        PG8_WAIT_V(6); PG8_BAR;
    }
    for (;;) {
        const bool has_next = S.next(ui + 1, nxt);
        const char* nA = has_next ? (const char*)g.A + (size_t)nxt.pm * tstepA : cA; const char* nB = has_next ? (const char*)g.Bt + (size_t)nxt.pn * tstepB : cB;
        for (int t = 0; t < nt; t += 2) {
            const bool last = (t == nt - 2);
            const char* a1 = cA + (size_t)(t + 1) * kstep;
            const char* a2 = last ? nA : cA + (size_t)(t + 2) * kstep; const char* b2 = last ? nB : cB + (size_t)(t + 2) * kstep;
            const char* a3 = a2 + kstep; const char* b3 = b2 + kstep;
            if (last && has_next) S.a_ready(nxt);
            if constexpr (SP2) {
            PG8_LDB(B0, 0, 0); PG8_LDB(B1, 0, 1); PG8_SCHED; PG8_LDA(At, 0, 0); PG8_STAGE(PG8_SA(1, 1), a1 + hstepA, voffA);
            PG8_WAIT_V(8); PG8_WAIT_L(0); PG8_BAR; PG8_MMA(0, 0, At, B0); PG8_MMA(0, 1, At, B1); PG8_BAR; PG8_SCHED;
            PG8_LDA(At, 0, 1); PG8_STAGE(PG8_SB(0, 0), b2, voffB); PG8_STAGE(PG8_SB(0, 1), b2 + hstepB, voffB); PG8_STAGE(PG8_SA(0, 0), a2, voffA);
            PG8_WAIT_V(8); PG8_WAIT_L(0); PG8_BAR; PG8_MMA(1, 0, At, B0); PG8_MMA(1, 1, At, B1); PG8_BAR; PG8_SCHED;
            PG8_LDB(B0, 1, 0); PG8_LDB(B1, 1, 1); PG8_SCHED; PG8_LDA(At, 1, 0); PG8_STAGE(PG8_SA(0, 1), a2 + hstepA, voffA);
            PG8_WAIT_V(8); PG8_WAIT_L(0); PG8_BAR; PG8_MMA(0, 0, At, B0); PG8_MMA(0, 1, At, B1); PG8_BAR; PG8_SCHED;
            PG8_LDA(At, 1, 1); PG8_STAGE(PG8_SB(1, 0), b3, voffB); PG8_STAGE(PG8_SB(1, 1), b3 + hstepB, voffB); PG8_STAGE(PG8_SA(1, 0), a3, voffA);
            PG8_WAIT_V(8); PG8_WAIT_L(0); PG8_BAR; PG8_MMA(1, 0, At, B0); PG8_MMA(1, 1, At, B1); PG8_BAR; PG8_SCHED;
            } else {
            PG8_LDB(B0, 0, 0); PG8_SCHED; PG8_LDA(At, 0, 0); PG8_STAGE(PG8_SA(1, 1), a1 + hstepA, voffA);
            PG8_WAIT_L(8); PG8_BAR; PG8_WAIT_L(0); PG8_MMA(0, 0, At, B0); PG8_BAR; PG8_SCHED;
            PG8_LDB(B1, 0, 1); PG8_STAGE(PG8_SB(0, 0), b2, voffB);
            PG8_BAR; PG8_WAIT_L(0); PG8_MMA(0, 1, At, B1); PG8_BAR;
            PG8_LDA(At, 0, 1); PG8_STAGE(PG8_SA(0, 0), a2, voffA);
            PG8_BAR; PG8_WAIT_L(0); PG8_MMA(1, 0, At, B0); PG8_BAR; PG8_SCHED;
            PG8_STAGE(PG8_SB(0, 1), b2 + hstepB, voffB);
            PG8_WAIT_V(6); PG8_BAR; PG8_MMA(1, 1, At, B1); PG8_BAR;
            PG8_LDB(B0, 1, 0); PG8_SCHED; PG8_LDA(At, 1, 0); PG8_STAGE(PG8_SA(0, 1), a2 + hstepA, voffA);
            PG8_WAIT_L(8); PG8_BAR; PG8_WAIT_L(0); PG8_MMA(0, 0, At, B0); PG8_BAR; PG8_SCHED;
            PG8_LDB(B1, 1, 1); PG8_STAGE(PG8_SB(1, 0), b3, voffB);
            PG8_BAR; PG8_WAIT_L(0); PG8_MMA(0, 1, At, B1); PG8_BAR;
            PG8_LDA(At, 1, 1); PG8_STAGE(PG8_SA(1, 0), a3, voffA);
            PG8_BAR; PG8_WAIT_L(0); PG8_MMA(1, 0, At, B0); PG8_BAR; PG8_SCHED;
            PG8_STAGE(PG8_SB(1, 1), b3 + hstepB, voffB);
            PG8_WAIT_V(6); PG8_BAR; PG8_MMA(1, 1, At, B1); PG8_BAR;
            }
        }
        if constexpr (ALIGN_EPI) { if (wr == 0) PG8_BAR; }
        if constexpr (!Epi::AFTER_DRAIN) { E(acc, cur, wr, wc, fr, fq); S.done(cur); }
        if (!has_next) break;
#pragma unroll
        for (int a = 0; a < 2; ++a)
#pragma unroll
            for (int b = 0; b < 2; ++b)
#pragma unroll
                for (int m = 0; m < 4; ++m)
#pragma unroll
                    for (int n = 0; n < 2; ++n) acc[a][b][m][n] = (f32x4){0.f, 0.f, 0.f, 0.f};
        cur = nxt; cA = nA; cB = nB; ++ui;
        if constexpr (ALIGN_EPI) { if (wr == 1) PG8_BAR; }
    }
    PG8_WAIT_V(0);
    if constexpr (!ALIGN_EPI) { if (wr == 0) PG8_BAR; }
    PG8_BAR;
#undef PG8_SA
#undef PG8_SB
#undef PG8_STAGE
#undef PG8_LDA
#undef PG8_LDB
#undef PG8_MMA
#undef PG8_WAIT_V
#undef PG8_WAIT_L
#undef PG8_BAR
#undef PG8_SCHED
}
}

#define XB_TMO      128
#define XB_XCNT(j)  (256  + 64 * (j))
#define XB_XSUB(j)  (1280 + 64 * (j))
#define XB_XGEN(j)  (2304 + 64 * (j))
#define XB_TOP      3328
#define XB_TOPGEN   3392
#define XCD_BAR_WORDS 3456
#define XB_SPIN_CAP (1u << 18)
__device__ __forceinline__ unsigned xb_ld(unsigned* p)              { return __hip_atomic_load(p, __ATOMIC_RELAXED, __HIP_MEMORY_SCOPE_AGENT); }
__device__ __forceinline__ unsigned xb_add(unsigned* p, unsigned v) { return __hip_atomic_fetch_add(p, v, __ATOMIC_RELAXED, __HIP_MEMORY_SCOPE_AGENT); }
__device__ __forceinline__ unsigned xb_xcc_id() { return (unsigned)__builtin_amdgcn_s_getreg((3 << 11) | 20) & 0xFu; }
#define XB_SPIN(cond, bar) do { unsigned _sp = 0; while (cond) { __builtin_amdgcn_s_sleep(1); \
    if ((++_sp & 255u) == 0u) { if (xb_ld(&(bar)[XB_TMO])) break; if (_sp > XB_SPIN_CAP) { atomicAdd(&(bar)[XB_TMO], 1u); break; } } } } while (0)
struct XcdBarrier { unsigned* bar; unsigned x; volatile LAS unsigned* st; };
__device__ __forceinline__ XcdBarrier xcd_barrier_post(unsigned* bar, volatile LAS unsigned* st) {
    XcdBarrier b; b.bar = bar; b.x = xb_xcc_id(); b.st = st;
    if (threadIdx.x == 0) (void)xb_add(&bar[XB_XCNT(b.x)], 1u);
    return b;
}
__device__ __forceinline__ void xcd_barrier_complete(unsigned* bar, unsigned x, unsigned& nloc, unsigned& nx) {
    const unsigned G = gridDim.x * gridDim.y * gridDim.z;
    unsigned sum, cnt, mine, sp = 0u;
    for (;;) {
        sum = 0u; cnt = 0u; mine = 0u;
#pragma unroll
        for (unsigned j = 0; j < 16; ++j) { const unsigned c = xb_ld(&bar[XB_XCNT(j)]); sum += c; cnt += (c > 0u) ? 1u : 0u; mine = (j == x) ? c : mine; }
        if (sum == G) break;
        __builtin_amdgcn_s_sleep(1);
        if ((++sp & 255u) == 0u) { if (xb_ld(&bar[XB_TMO])) break; if (sp > XB_SPIN_CAP) { atomicAdd(&bar[XB_TMO], 1u); break; } }
    }
    nloc = mine > 0u ? mine : 1u; nx = cnt > 0u ? cnt : 1u;
}
__device__ __forceinline__ void xcd_barrier(const XcdBarrier& b) {
    asm volatile("s_waitcnt vmcnt(0)" ::: "memory");
    __syncthreads();
    if (threadIdx.x == 0) {
        unsigned* bar = b.bar;
        __builtin_amdgcn_s_waitcnt(0);
        unsigned nloc = b.st[0], nx = b.st[1];
        if (nloc == 0u) { xcd_barrier_complete(bar, b.x, nloc, nx); b.st[0] = nloc; b.st[1] = nx; }
        const unsigned old = xb_add(&bar[XB_XSUB(b.x)], 1u);
        const unsigned gen = old / nloc;
        if (old + 1u == (gen + 1u) * nloc) {
            __builtin_amdgcn_fence(__ATOMIC_RELEASE, "agent");
            asm volatile("s_waitcnt vmcnt(0)" ::: "memory");
            const unsigned og = xb_add(&bar[XB_TOP], 1u);
            const unsigned tg = og / nx;
            if (og + 1u == (tg + 1u) * nx) xb_add(&bar[XB_TOPGEN], 1u);
            else XB_SPIN(xb_ld(&bar[XB_TOPGEN]) == tg, bar);
            __builtin_amdgcn_fence(__ATOMIC_ACQUIRE, "agent");
            xb_add(&bar[XB_XGEN(b.x)], 1u);
            asm volatile("s_waitcnt vmcnt(0)" ::: "memory");
        } else {
            XB_SPIN(xb_ld(&bar[XB_XGEN(b.x)]) == gen, bar);
            __builtin_amdgcn_fence(__ATOMIC_ACQUIRE, "agent");
            asm volatile("s_waitcnt vmcnt(0)" ::: "memory");
        }
    }
    __syncthreads();
}

constexpr int RING_OFF = 0, RING_BYTES = 131072;
constexpr int LDSCTL_OFF = RING_BYTES, MISC_OFF = LDSCTL_OFF + 320;
constexpr int SCR_OFF = RING_BYTES + 1024;
constexpr int LDS_BYTES = 147456;
constexpr int NWAVES = 8;

struct Args { const float* in[28]; float* out; unsigned char* ws; int ph_lo, ph_hi, li, pad; };

struct Frame {
    LAS unsigned char* lds;
    int tid, lane, wave, vcu, G;
};

__device__ __forceinline__ void tr_item(const float* W, int ldw, int K, int srccol, bf16* WT, int dstrow, int k0, LAS float* scr, int lane) {
#pragma unroll 8
    for (int i = 0; i < 32; ++i) { const int kk = 2 * i + (lane >> 5); scr[kk * 33 + (lane & 31)] = W[(size_t)(k0 + kk) * ldw + srccol + (lane & 31)]; }
    LDS_WAIT(); asm volatile("" ::: "memory");
    const int c = lane & 7;
#pragma unroll
    for (int j = 0; j < 4; ++j) { const int n = (lane >> 3) + 8 * j; const LAS float* s = scr + (8 * c) * 33 + n;
        v4u o; o.x = pk2(s[0 * 33], s[1 * 33]); o.y = pk2(s[2 * 33], s[3 * 33]); o.z = pk2(s[4 * 33], s[5 * 33]); o.w = pk2(s[6 * 33], s[7 * 33]);
        *(GAS v4u*)(WT + (size_t)(dstrow + n) * K + k0 + 8 * c) = o; }
    LDS_WAIT(); asm volatile("" ::: "memory");
}
struct TrSeg { const float* W; int ldw, K, srccol, N; bf16* WT; int dst0, mode; };
__device__ __forceinline__ void tr_seg_item(const TrSeg& s, int item, LAS float* scr, int lane) {
    const int nblk = s.N / 32, kb = item / nblk, nb = item % nblk, n0 = 32 * nb;
    int dstrow = s.dst0 + n0;
    if (s.mode) dstrow = 256 * (n0 >> 7) + (n0 & 127) + (s.mode == 2 ? 128 : 0);
    tr_item(s.W, s.ldw, s.K, s.srccol + n0, s.WT, dstrow, 64 * kb, scr, lane);
}
__device__ __forceinline__ void phase_prologue(const Frame& F, const Args& a) {
    unsigned char* ws = a.ws;
    if (blockIdx.x < 192) {
        const int cg = blockIdx.x, l = cg / 96, col = (cg % 96) * 64 + F.lane;
        const float* W = a.in[2] + (size_t)l * DM * 6144; const float* cv = a.in[1];
        float a0 = 0.f, a1 = 0.f;
        const int k0 = F.wave * 128;
#pragma unroll 4
        for (int k = k0; k < k0 + 128; ++k) { const float w = W[(size_t)k * 6144 + col]; a0 += silu_f(cv[k]) * w; a1 += silu_f(cv[DM + k]) * w; }
        LAS float* red = (LAS float*)(F.lds + SCR_OFF);
        red[(F.wave * 2 + 0) * 64 + F.lane] = a0; red[(F.wave * 2 + 1) * 64 + F.lane] = a1;
        __syncthreads();
        if (F.wave < 2) { float s = 0.f;
#pragma unroll
            for (int w = 0; w < 8; ++w) s += red[(w * 2 + F.wave) * 64 + F.lane];
            float* MOD = (float*)(ws + WS_MOD);
            MOD[((size_t)l * 2 + F.wave) * 6144 + col] = s + a.in[3][(size_t)l * 6144 + col]; }
        __syncthreads();
    }
    { bf16* WST = (bf16*)(ws + WS_WST); const float* wsrc = a.in[15];
      for (int i = blockIdx.x * 512 + F.tid; i < 8 * 128 * 128; i += F.G * 512) { const int t = (i >> 7) & 127, s = i & 127; WST[i] = (s <= t) ? (bf16)f2bf(wsrc[i]) : (bf16)0; } }
    LAS float* scr = (LAS float*)(F.lds + RING_OFF + F.wave * 16384);
    const int gw = F.vcu * NWAVES + F.wave, NGW = F.G * NWAVES;
    const float* in_w = a.in[6];
    int base = 0;
#define TR_SEG(Wp, ldw_, K_, srccol_, N_, WTp, dst0_, mode_) do { const TrSeg sg{(Wp), (ldw_), (K_), (srccol_), (N_), (WTp), (dst0_), (mode_)}; \
        const int cnt = ((K_) / 64) * ((N_) / 32); const int first = ((gw - base) % NGW + NGW) % NGW; \
        for (int j = first; j < cnt; j += NGW) tr_seg_item(sg, j, scr, F.lane); base += cnt; } while (0)
    TR_SEG(in_w, IN_EVEN, DM, 0, 1024, (bf16*)(ws + WS_WIN), 0, 0);
    TR_SEG(in_w, IN_EVEN, DM, 2576, 1024, (bf16*)(ws + WS_WIN), 1024, 0);
    TR_SEG(in_w, IN_EVEN, DM, 1024, 1536, (bf16*)(ws + WS_WIN), 2048, 0);
    TR_SEG(in_w, IN_EVEN, DM, 3600, 1024, (bf16*)(ws + WS_WIN), 3584, 0);
    TR_SEG(a.in[17], DM, 2048, 0, 1024, (bf16*)(ws + WS_WOUT), 0, 0);
    TR_SEG(a.in[18], QKVD, DM, 0, QKVD, (bf16*)(ws + WS_WQKV), 0, 0);
    TR_SEG(a.in[20], DM, DM, 0, DM, (bf16*)(ws + WS_WO), 0, 0);
    TR_SEG(a.in[24], FFN, DM, 0, FFN, (bf16*)(ws + WS_WGU), 0, 1);
    TR_SEG(a.in[25], FFN, DM, 0, FFN, (bf16*)(ws + WS_WGU), 0, 2);
    TR_SEG(a.in[24] + (size_t)DM * FFN, FFN, DM, 0, FFN, (bf16*)(ws + WS_WGU) + (size_t)NGU * DM, 0, 1);
    TR_SEG(a.in[25] + (size_t)DM * FFN, FFN, DM, 0, FFN, (bf16*)(ws + WS_WGU) + (size_t)NGU * DM, 0, 2);
    TR_SEG(a.in[26], DM, FFN, 0, DM, (bf16*)(ws + WS_WD), 0, 0);
    TR_SEG(a.in[26] + (size_t)FFN * DM, DM, FFN, 0, DM, (bf16*)(ws + WS_WD) + (size_t)DM * FFN, 0, 0);
#undef TR_SEG
}

template <int MODE>
__device__ __forceinline__ void phase_norm(const Frame& F, const float* xin, const float* w, const float* sh, const float* sc, bf16* xn, float* fout,
                                           const float* in_w, const float* dt_bias, float* DT) {
    LAS float* wdt = (LAS float*)(F.lds + RING_OFF);
    if constexpr (MODE == 1) {
        for (int i = F.tid; i < 16 * 1024; i += 512) { const int k = i >> 4, j = i & 15; wdt[j * 1024 + k] = in_w[(size_t)k * IN_EVEN + 2560 + j]; }
        __syncthreads();
    }
    const int gw = F.vcu * NWAVES + F.wave, NGW = F.G * NWAVES;
    const int lane = F.lane;
    for (int b = 0; b < BATCH; ++b) {
        f32x4 A[4], Bv[4];
#pragma unroll
        for (int j = 0; j < 4; ++j) { const int col = 4 * lane + 256 * j; const f32x4 wv = *(const f32x4*)(w + col);
            if constexpr (MODE == 2) { A[j] = wv; Bv[j] = (f32x4){0.f, 0.f, 0.f, 0.f}; }
            else { const f32x4 s = *(const f32x4*)(sc + (size_t)b * 6144 + col); A[j] = wv * (s + 1.0f); Bv[j] = *(const f32x4*)(sh + (size_t)b * 6144 + col); } }
        for (int m = b * SEQ + gw; m < (b + 1) * SEQ; m += NGW) {
            const GAS f32x4* xr = (const GAS f32x4*)(xin + (size_t)m * DM) + lane;
            f32x4 v[4]; float s = 0.f;
#pragma unroll
            for (int j = 0; j < 4; ++j) { v[j] = xr[64 * j]; s += (v[j].x * v[j].x + v[j].y * v[j].y) + (v[j].z * v[j].z + v[j].w * v[j].w); }
            const float rstd = 1.0f / sqrtf(wave_sum(s) * (1.0f / DM) + EPS);
#pragma unroll
            for (int j = 0; j < 4; ++j) v[j] = v[j] * rstd * A[j] + Bv[j];
            if constexpr (MODE == 2) {
                GAS f32x4* o = (GAS f32x4*)(fout + (size_t)m * DM) + lane;
#pragma unroll
                for (int j = 0; j < 4; ++j) o[64 * j] = v[j];
            } else {
                GAS unsigned long long* o8 = (GAS unsigned long long*)(xn + (size_t)m * DM) + lane;
#pragma unroll
                for (int j = 0; j < 4; ++j) o8[64 * j] = (unsigned long long)pk2(v[j].x, v[j].y) | ((unsigned long long)pk2(v[j].z, v[j].w) << 32);
            }
            if constexpr (MODE == 1) {
                float mine = 0.f;
#pragma unroll 1
                for (int jj = 0; jj < 16; ++jj) { float p = 0.f; asm volatile("" ::: "memory");
#pragma unroll
                    for (int j = 0; j < 4; ++j) { const f32x4 wv = *(const LAS f32x4*)(wdt + jj * 1024 + 4 * lane + 256 * j); p += (v[j].x * wv.x + v[j].y * wv.y) + (v[j].z * wv.z + v[j].w * wv.w); }
                    p = wave_sum(p); if (lane == jj) mine = p; }
                if (lane < 16) { const float xv = mine + dt_bias[lane]; DT[(size_t)m * 16 + lane] = xv > 20.f ? xv : log1pf(__expf(xv)); }
            }
        }
    }
}

__device__ __forceinline__ void phase_scan(const Frame& F, bf16* ST, const float* CD) {
    for (int idx = blockIdx.x * 512 + F.tid; idx < 2 * 16 * 64 * 64; idx += F.G * 512) {
        const int n2 = idx & 63, p = (idx >> 6) & 63, h = (idx >> 12) & 15, b = idx >> 16;
        float r0 = 0.f, r1 = 0.f;
#pragma unroll 4
        for (int c = 0; c < NCH; ++c) {
            const size_t off = ((size_t)((b * NCH + c) * NHEAD + h) * HDIM + p) * NSTATE + 2 * n2;
            const unsigned v = *(const unsigned*)(ST + off);
            *(unsigned*)(ST + off) = pk2(r0, r1);
            const float d = CD[(b * NCH + c) * NHEAD + h];
            r0 = r0 * d + bf2f((unsigned short)(v & 0xffffu)); r1 = r1 * d + bf2f((unsigned short)(v >> 16));
        }
    }
}

enum { PH_PRO = 0, PH_NORM0, PH_INPROJ, PH_MIXA, PH_SCAN, PH_MIXC, PH_OUTPROJ, PH_NORM1, PH_UP0, PH_DOWN0, PH_NORM2, PH_QKV, PH_ATTN, PH_OPROJ, PH_NORM3, PH_UP1, PH_DOWN1, PH_FINAL, PH_COUNT };

__global__ void __launch_bounds__(NWAVES * 64, 2) mk_fwd(Args args) {
    extern __shared__ __attribute__((aligned(16))) unsigned char lds[];
    Frame F;
    F.lds = (LAS unsigned char*)lds;
    F.tid = threadIdx.x; F.lane = F.tid & 63; F.wave = __builtin_amdgcn_readfirstlane(F.tid >> 6);
    F.G = gridDim.x; { const int bx = blockIdx.x; F.vcu = (F.G % 8 == 0) ? (bx % 8) * (F.G / 8) + bx / 8 : bx; }
    unsigned char* ws = args.ws;
    gu32* ctl = (gu32*)(ws + WS_CTL);
    volatile LAS unsigned* MISC = (volatile LAS unsigned*)(F.lds + MISC_OFF);
    for (int u = F.tid; u < (SCR_OFF - LDSCTL_OFF) / 4; u += NWAVES * 64) ((LAS unsigned*)(F.lds + LDSCTL_OFF))[u] = 0u;
    __syncthreads();
    const int lo = args.ph_lo, hi = args.ph_hi;
    XcdBarrier bar; bar.bar = (unsigned*)(ctl + CW_BAR) + args.li * XCD_BAR_WORDS; bar.x = 0; bar.st = nullptr;
    if (hi - lo > 1) bar = xcd_barrier_post((unsigned*)(ctl + CW_BAR) + args.li * XCD_BAR_WORDS, MISC + 8);
#define IN(k) (lo <= (k) && (k) < hi)
#define SEAM(k) do { if (IN(k) && IN((k) + 1)) xcd_barrier(bar); } while (0)

    float* MOD = (float*)(ws + WS_MOD);
    bf16* XN = (bf16*)(ws + WS_XN); bf16* PROJ = (bf16*)(ws + WS_PROJ); bf16* HB = (bf16*)(ws + WS_H);
    bf16* QKV = (bf16*)(ws + WS_QKV); bf16* AO = (bf16*)(ws + WS_AO);
    float* out = args.out;
    const float* MOD0 = MOD; const float* MOD1 = MOD + 2 * 6144;

    if (IN(PH_PRO)) { phase_prologue(F, args); } SEAM(PH_PRO);
    if (IN(PH_NORM0)) { phase_norm<1>(F, args.in[0], args.in[4], MOD0 + 0, MOD0 + 1024, XN, nullptr, args.in[6], args.in[9], (float*)(ws + WS_DT)); __syncthreads(); } SEAM(PH_NORM0);
    if (IN(PH_INPROJ)) {
        pg8::Gemm g{XN, (const bf16*)(ws + WS_WIN), MTOK, NPROJ, DM, DM}; pg8::StaticOrder S; S.init(MTOK, NPROJ, F.G, (int)blockIdx.x);
        pg8::EpiProj E{PROJ, (bf16*)(ws + WS_HALO)};
        pg8::gemm_phase<pg8::EpiProj, pg8::StaticOrder, true, true>(F.lds + RING_OFF, g, S, E);
    } SEAM(PH_INPROJ);
    SEAM(PH_MIXA);
    if (IN(PH_SCAN)) { phase_scan(F, (bf16*)(ws + WS_ST), (const float*)(ws + WS_CD)); } SEAM(PH_SCAN);
    SEAM(PH_MIXC);
    if (IN(PH_OUTPROJ)) {
        pg8::Gemm g{PROJ, (const bf16*)(ws + WS_WOUT), MTOK, DM, 2048, NPROJ}; pg8::StaticOrder S; S.init(MTOK, DM, F.G, (int)blockIdx.x);
        pg8::EpiRes E{args.in[0], out, nullptr, MOD0 + 2048};
        pg8::gemm_phase<pg8::EpiRes, pg8::StaticOrder, true, true>(F.lds + RING_OFF, g, S, E);
    } SEAM(PH_OUTPROJ);
    if (IN(PH_NORM1)) { phase_norm<0>(F, out, args.in[5], MOD0 + 3072, MOD0 + 4096, XN, nullptr, nullptr, nullptr, nullptr); } SEAM(PH_NORM1);
    if (IN(PH_UP0)) {
        pg8::Gemm g{XN, (const bf16*)(ws + WS_WGU), MTOK, NGU, DM, DM}; pg8::StaticOrder S; S.init(MTOK, NGU, F.G, (int)blockIdx.x);
        pg8::EpiSwiGLU E{HB};
        pg8::gemm_phase<pg8::EpiSwiGLU, pg8::StaticOrder, true, true>(F.lds + RING_OFF, g, S, E);
    } SEAM(PH_UP0);
    if (IN(PH_DOWN0)) {
        pg8::Gemm g{HB, (const bf16*)(ws + WS_WD), MTOK, DM, FFN, FFN}; pg8::StaticOrder S; S.init(MTOK, DM, F.G, (int)blockIdx.x);
        pg8::EpiRes E{out, out, nullptr, MOD0 + 5120};
        pg8::gemm_phase<pg8::EpiRes, pg8::StaticOrder, true, true>(F.lds + RING_OFF, g, S, E);
    } SEAM(PH_DOWN0);
    if (IN(PH_NORM2)) { phase_norm<0>(F, out, args.in[4] + DM, MOD1 + 0, MOD1 + 1024, XN, nullptr, nullptr, nullptr, nullptr); } SEAM(PH_NORM2);
    if (IN(PH_QKV)) {
        pg8::Gemm g{XN, (const bf16*)(ws + WS_WQKV), MTOK, QKVD, DM, DM}; pg8::StaticOrder S; S.init(MTOK, QKVD, F.G, (int)blockIdx.x);
        pg8::EpiBf16 E{QKV, QKVD, args.in[19]};
        pg8::gemm_phase<pg8::EpiBf16, pg8::StaticOrder, true, true>(F.lds + RING_OFF, g, S, E);
    } SEAM(PH_QKV);
    SEAM(PH_ATTN);
    if (IN(PH_OPROJ)) {
        pg8::Gemm g{AO, (const bf16*)(ws + WS_WO), MTOK, DM, DM, DM}; pg8::StaticOrder S; S.init(MTOK, DM, F.G, (int)blockIdx.x);
        pg8::EpiRes E{out, out, args.in[21], MOD1 + 2048};
        pg8::gemm_phase<pg8::EpiRes, pg8::StaticOrder, true, true>(F.lds + RING_OFF, g, S, E);
    } SEAM(PH_OPROJ);
    if (IN(PH_NORM3)) { phase_norm<0>(F, out, args.in[5] + DM, MOD1 + 3072, MOD1 + 4096, XN, nullptr, nullptr, nullptr, nullptr); } SEAM(PH_NORM3);
    if (IN(PH_UP1)) {
        pg8::Gemm g{XN, (const bf16*)(ws + WS_WGU) + (size_t)NGU * DM, MTOK, NGU, DM, DM}; pg8::StaticOrder S; S.init(MTOK, NGU, F.G, (int)blockIdx.x);
        pg8::EpiSwiGLU E{HB};
        pg8::gemm_phase<pg8::EpiSwiGLU, pg8::StaticOrder, true, true>(F.lds + RING_OFF, g, S, E);
    } SEAM(PH_UP1);
    if (IN(PH_DOWN1)) {
        pg8::Gemm g{HB, (const bf16*)(ws + WS_WD) + (size_t)DM * FFN, MTOK, DM, FFN, FFN}; pg8::StaticOrder S; S.init(MTOK, DM, F.G, (int)blockIdx.x);
        pg8::EpiRes E{out, out, nullptr, MOD1 + 5120};
        pg8::gemm_phase<pg8::EpiRes, pg8::StaticOrder, true, true>(F.lds + RING_OFF, g, S, E);
    } SEAM(PH_DOWN1);
    if (IN(PH_FINAL)) { phase_norm<2>(F, out, args.in[27], nullptr, nullptr, nullptr, out, nullptr, nullptr, nullptr); }
#undef IN
#undef SEAM
}

__global__ void nv_conv(bf16* PROJ, const bf16* HALO, const float* conv_w, const float* conv_b) {
    const int bc = blockIdx.x / 6, ch = (blockIdx.x % 6) * 256 + threadIdx.x; const int c = bc % NCH;
    float r0 = 0.f, r1 = 0.f, r2 = 0.f;
    if (c > 0) { const bf16* hp = HALO + ((size_t)bc * 3) * CONVD + ch; r0 = bf2f(hp[0]); r1 = bf2f(hp[CONVD]); r2 = bf2f(hp[2 * CONVD]); }
    const float w0 = conv_w[ch], w1 = conv_w[CONVD + ch], w2 = conv_w[2 * CONVD + ch], w3 = conv_w[3 * CONVD + ch], cb = conv_b[ch];
    bf16* p = PROJ + (size_t)bc * CHUNK * NPROJ + PJ_X + ch;
    for (int t = 0; t < CHUNK; ++t) { const float r3 = bf2f(p[(size_t)t * NPROJ]); const float a = cb + w0 * r0 + w1 * r1 + w2 * r2 + w3 * r3;
        p[(size_t)t * NPROJ] = (bf16)f2bf(silu_f(a)); r0 = r1; r1 = r2; r2 = r3; }
}
__global__ void nv_cumsum(const float* DT, const float* a_log, float* LAC, float* CD) {
    const int idx = blockIdx.x * blockDim.x + threadIdx.x; if (idx >= BATCH * NCH * NHEAD) return;
    const int h = idx % NHEAD, bc = idx / NHEAD; const float a = -expf(a_log[h]); float run = 0.f;
    for (int l = 0; l < CHUNK; ++l) { run += DT[(size_t)(bc * CHUNK + l) * 16 + h] * a; LAC[(size_t)(bc * NHEAD + h) * CHUNK + l] = run; }
    CD[bc * NHEAD + h] = expf(run);
}
__global__ void __launch_bounds__(256) nv_states(const bf16* PROJ, const float* DT, const float* LAC, bf16* ST) {
    const int bch = blockIdx.x, h = bch % NHEAD, bc = bch / NHEAD, g = h / 8, tid = threadIdx.x;
    __shared__ float wgt[CHUNK]; __shared__ float xs_s[CHUNK][HDIM];
    const float* lacp = LAC + (size_t)(bc * NHEAD + h) * CHUNK; const float last = lacp[CHUNK - 1];
    for (int s = tid; s < CHUNK; s += 256) wgt[s] = DT[(size_t)(bc * CHUNK + s) * 16 + h] * expf(last - lacp[s]);
    __syncthreads();
    for (int i = tid; i < CHUNK * HDIM; i += 256) { const int s = i >> 6, p = i & 63; xs_s[s][p] = bf2f(PROJ[(size_t)(bc * CHUNK + s) * NPROJ + PJ_X + h * HDIM + p]) * wgt[s]; }
    __syncthreads();
    const int n = tid & 127, ph = tid >> 7;
    float acc[32];
#pragma unroll
    for (int j = 0; j < 32; ++j) acc[j] = 0.f;
    for (int s = 0; s < CHUNK; ++s) { const float bv = bf2f(PROJ[(size_t)(bc * CHUNK + s) * NPROJ + PJ_B + g * NSTATE + n]);
#pragma unroll
        for (int j = 0; j < 32; ++j) acc[j] += xs_s[s][ph * 32 + j] * bv; }
#pragma unroll
    for (int j = 0; j < 32; ++j) ST[((size_t)(bc * NHEAD + h) * HDIM + ph * 32 + j) * NSTATE + n] = (bf16)f2bf(acc[j]);
}
__global__ void __launch_bounds__(256) nv_cb(const bf16* PROJ, float* CBG) {
    const int bcg = blockIdx.x, g = bcg & 1, bc = bcg >> 1, tid = threadIdx.x;
    __shared__ float Bc[CHUNK][129]; __shared__ float Cc[CHUNK][129];
    for (int i = tid; i < CHUNK * NSTATE; i += 256) { const int s = i >> 7, n = i & 127; const bf16* row = PROJ + (size_t)(bc * CHUNK + s) * NPROJ;
        Bc[s][n] = bf2f(row[PJ_B + g * NSTATE + n]); Cc[s][n] = bf2f(row[PJ_C + g * NSTATE + n]); }
    __syncthreads();
    const int s = tid & 127, lh = tid >> 7;
    for (int l = lh * 64; l < lh * 64 + 64; ++l) { float a = 0.f;
        for (int n = 0; n < NSTATE; ++n) a += Cc[l][n] * Bc[s][n];
        CBG[((size_t)bcg * CHUNK + l) * CHUNK + s] = a; }
}
__global__ void __launch_bounds__(512) nv_ssd_out(bf16* PROJ, const float* DT, const float* LAC, const bf16* PREV, const float* CBG, const float* d_skip, const float* norm_w) {
    const int m = blockIdx.x >> 1, g = blockIdx.x & 1, tid = threadIdx.x, j = tid >> 6, p = tid & 63, h = g * 8 + j, l = m & 127, bc = m >> 7;
    __shared__ float cb_row[CHUNK], cvec[NSTATE], lac_s[8][CHUNK], dt_s[8][CHUNK], red[8];
    if (tid < 128) cb_row[tid] = CBG[((size_t)(bc * 2 + g) * CHUNK + l) * CHUNK + tid];
    else if (tid < 256) cvec[tid - 128] = bf2f(PROJ[(size_t)m * NPROJ + PJ_C + g * NSTATE + (tid - 128)]);
    for (int i = tid; i < 8 * CHUNK; i += 512) { const int jj = i >> 7, s = i & 127; lac_s[jj][s] = LAC[(size_t)(bc * NHEAD + g * 8 + jj) * CHUNK + s]; dt_s[jj][s] = DT[(size_t)(bc * CHUNK + s) * 16 + g * 8 + jj]; }
    __syncthreads();
    const float lacl = lac_s[j][l];
    float y = 0.f;
    for (int s = 0; s <= l; ++s) y += cb_row[s] * expf(lacl - lac_s[j][s]) * dt_s[j][s] * bf2f(PROJ[(size_t)(bc * CHUNK + s) * NPROJ + PJ_X + h * HDIM + p]);
    float yo = 0.f;
    const bf16* pv = PREV + ((size_t)(bc * NHEAD + h) * HDIM + p) * NSTATE;
    for (int n = 0; n < NSTATE; ++n) yo += cvec[n] * bf2f(pv[n]);
    y += yo * expf(lacl);
    y += d_skip[h] * bf2f(PROJ[(size_t)m * NPROJ + PJ_X + h * HDIM + p]);
    y *= bf2f(PROJ[(size_t)m * NPROJ + PJ_Z + h * HDIM + p]);
    float ss = wave_sum(y * y);
    if (p == 0) red[j] = ss;
    __syncthreads();
    float tot = 0.f;
#pragma unroll
    for (int q = 0; q < 8; ++q) tot += red[q];
    const float rstd = 1.0f / sqrtf(tot * (1.0f / 512.0f) + EPS);
    PROJ[(size_t)m * NPROJ + PJ_Z + h * HDIM + p] = (bf16)f2bf(y * rstd * norm_w[h * HDIM + p]);
}
__global__ void __launch_bounds__(256) nv_gmlp_stats(const bf16* PROJ, float* VST) {
    const int m = blockIdx.x * 4 + (threadIdx.x >> 6), lane = threadIdx.x & 63;
    const bf16* row = PROJ + (size_t)m * NPROJ + PJ_V;
    float v[16]; float s = 0.f;
#pragma unroll
    for (int i = 0; i < 16; ++i) { v[i] = bf2f(row[lane + 64 * i]); s += v[i]; }
    const float mean = wave_sum(s) * (1.0f / 1024.0f); float q = 0.f;
#pragma unroll
    for (int i = 0; i < 16; ++i) { const float d = v[i] - mean; q += d * d; }
    const float rstd = 1.0f / sqrtf(wave_sum(q) * (1.0f / 1024.0f) + EPS);
    if (lane == 0) { VST[2 * m] = mean; VST[2 * m + 1] = rstd; }
}
__global__ void __launch_bounds__(512) nv_gmlp_out(bf16* PROJ, const float* VST, const float* wsp, const float* bs, const float* lnw, const float* lnb) {
    const int m = blockIdx.x, t = m & 127, r0 = m - t, tid = threadIdx.x;
    __shared__ float mu[CHUNK], rs[CHUNK], wrow[8][CHUNK];
    if (tid < 128) { mu[tid] = VST[2 * (r0 + tid)]; rs[tid] = VST[2 * (r0 + tid) + 1]; }
    for (int i = tid; i < 8 * CHUNK; i += 512) { const int g = i >> 7, s = i & 127; wrow[g][s] = wsp[((size_t)g * CHUNK + t) * CHUNK + s]; }
    __syncthreads();
    for (int f = tid; f < 1024; f += 512) { const int g = f >> 7; const float lw = lnw[f], lb = lnb[f]; float sv = 0.f;
        for (int s = 0; s <= t; ++s) sv += wrow[g][s] * ((bf2f(PROJ[(size_t)(r0 + s) * NPROJ + PJ_V + f]) - mu[s]) * rs[s] * lw + lb);
        const float uu = bf2f(PROJ[(size_t)m * NPROJ + PJ_U + f]);
        PROJ[(size_t)m * NPROJ + PJ_U + f] = (bf16)f2bf(uu * (sv + bs[g * CHUNK + t])); }
}
__global__ void __launch_bounds__(64) nv_attn(const bf16* QKV, bf16* AO, const float* sinks, const float* table) {
    const int head = blockIdx.x & 15, m = (blockIdx.x >> 4) * 64 + threadIdx.x, t = m & (SEQ - 1), kvh = head >> 3;
    float q[64], o[64];
#pragma unroll
    for (int d = 0; d < 64; ++d) { q[d] = bf2f(QKV[(size_t)m * QKVD + head * 64 + d]); o[d] = 0.f; }
    float mrun = sinks[head], lsum = 1.0f;
    for (int j = 0; j < 128; ++j) { const int tk = t - 127 + j; if (tk < 0) continue; const int rel = 127 - j;
        const bf16* kr = QKV + (size_t)(m - rel) * QKVD + 1024 + kvh * 64; const bf16* vr = kr + 128;
        float s = 0.f;
#pragma unroll
        for (int d = 0; d < 64; ++d) s += q[d] * bf2f(kr[d]);
        int bucket = rel; if (rel >= 16) { int lg = 16 + (int)(logf((float)rel * (1.0f / 16.0f)) / logf(8.0f) * 16.0f); bucket = lg < 31 ? lg : 31; }
        s = s * 0.125f + table[bucket * 16 + head];
        const float mn = fmaxf(mrun, s), f = expf(mrun - mn), pp = expf(s - mn);
        lsum = lsum * f + pp;
#pragma unroll
        for (int d = 0; d < 64; ++d) o[d] = o[d] * f + pp * bf2f(vr[d]);
        mrun = mn; }
    const float inv = 1.0f / lsum;
#pragma unroll
    for (int d = 0; d < 64; ++d) AO[(size_t)m * DM + head * 64 + d] = (bf16)f2bf(o[d] * inv);
}

extern "C" void kernel_launch(void* const* d_in, const int* in_sizes, int n_in, void* d_out, int out_size, void* d_ws, size_t ws_size, hipStream_t stream) {
    static int grid = 0;
    if (grid == 0) {
        if (n_in != 28 || in_sizes[0] != MTOK * DM || out_size != MTOK * DM || ws_size < WS_END) { fprintf(stderr, "kernel_launch: unexpected shapes (n_in %d, in0 %d, out %d, ws %zu)\n", n_in, n_in > 0 ? in_sizes[0] : -1, out_size, ws_size); grid = -1; return; }
        int dev = 0, cus = 0;
        if (hipGetDevice(&dev) != hipSuccess || hipDeviceGetAttribute(&cus, hipDeviceAttributeMultiprocessorCount, dev) != hipSuccess) { grid = -1; return; }
        if (hipFuncSetAttribute((const void*)mk_fwd, hipFuncAttributeMaxDynamicSharedMemorySize, LDS_BYTES) != hipSuccess) { fprintf(stderr, "kernel_launch: hipFuncSetAttribute failed\n"); grid = -1; return; }
        (void)hipGetLastError();
        grid = cus;
    }
    if (grid < 0) return;
    (void)hipMemsetAsync((char*)d_ws + WS_CTL, 0, CTL_ZERO_BYTES, stream);
    Args a{};
    for (int i = 0; i < 28; ++i) a.in[i] = (const float*)d_in[i];
    a.out = (float*)d_out; a.ws = (unsigned char*)d_ws;
    unsigned char* ws = (unsigned char*)d_ws;
    int li = 0;
    auto launch = [&](int lo, int hi) { a.ph_lo = lo; a.ph_hi = hi; a.li = li++; hipLaunchKernelGGL(mk_fwd, dim3(grid), dim3(NWAVES * 64), LDS_BYTES, stream, a); };
#if MK_NAIVE
    bf16* PROJ = (bf16*)(ws + WS_PROJ); float* DT = (float*)(ws + WS_DT); float* LAC = (float*)(ws + WS_LAC); float* CD = (float*)(ws + WS_CD);
    bf16* ST = (bf16*)(ws + WS_ST); float* CBG = (float*)(ws + WS_CBG); float* VST = (float*)(ws + WS_VST);
    launch(PH_PRO, PH_PRO + 1); launch(PH_NORM0, PH_NORM0 + 1); launch(PH_INPROJ, PH_INPROJ + 1);
    hipLaunchKernelGGL(nv_conv, dim3(128 * 6), dim3(256), 0, stream, PROJ, (const bf16*)(ws + WS_HALO), a.in[7], a.in[8]);
    hipLaunchKernelGGL(nv_cumsum, dim3(8), dim3(256), 0, stream, DT, a.in[10], LAC, CD);
    hipLaunchKernelGGL(nv_states, dim3(2048), dim3(256), 0, stream, PROJ, DT, LAC, ST);
    hipLaunchKernelGGL(nv_gmlp_stats, dim3(MTOK / 4), dim3(256), 0, stream, PROJ, VST);
    hipLaunchKernelGGL(nv_gmlp_out, dim3(MTOK), dim3(512), 0, stream, PROJ, VST, a.in[15], a.in[16], a.in[13], a.in[14]);
    launch(PH_SCAN, PH_SCAN + 1);
    hipLaunchKernelGGL(nv_cb, dim3(256), dim3(256), 0, stream, PROJ, CBG);
    hipLaunchKernelGGL(nv_ssd_out, dim3(MTOK * 2), dim3(512), 0, stream, PROJ, DT, LAC, ST, CBG, a.in[11], a.in[12]);
    for (int ph = PH_OUTPROJ; ph <= PH_QKV; ++ph) launch(ph, ph + 1);
    hipLaunchKernelGGL(nv_attn, dim3((MTOK / 64) * 16), dim3(64), 0, stream, (const bf16*)(ws + WS_QKV), (bf16*)(ws + WS_AO), a.in[22], a.in[23]);
    for (int ph = PH_OPROJ; ph <= PH_FINAL; ++ph) launch(ph, ph + 1);
#else
    launch(0, PH_COUNT);
#endif
}
```

```cpp
#include <hip/hip_runtime.h>
#include <cstdio>
#include <cstdint>

#ifndef MK_ONE_LAUNCH
#define MK_ONE_LAUNCH 0
#endif
#ifndef MK_NAIVE
#define MK_NAIVE 1
#endif

#define GAS __attribute__((address_space(1)))
#define LAS __attribute__((address_space(3)))
typedef unsigned short bf16;
typedef unsigned v4u __attribute__((ext_vector_type(4)));
typedef unsigned v2u __attribute__((ext_vector_type(2)));
typedef float f32x4 __attribute__((ext_vector_type(4)));
typedef float f32x2 __attribute__((ext_vector_type(2)));
typedef float f32x16 __attribute__((ext_vector_type(16)));
typedef short bf16x8 __attribute__((ext_vector_type(8)));
typedef GAS unsigned gu32;

constexpr int BATCH = 2, SEQ = 8192, DM = 1024, MTOK = BATCH * SEQ;
constexpr int IN_EVEN = 4624, NPROJ = 4608;
constexpr int PJ_Z = 0, PJ_U = 1024, PJ_X = 2048, PJ_B = 3072, PJ_C = 3328, PJ_V = 3584;
constexpr int FFN = 2816, NGU = 5632, QKVD = 1280;
constexpr int NCH = 64, CHUNK = 128, NHEAD = 16, HDIM = 64, NSTATE = 128, CONVD = 1536;
constexpr float EPS = 1e-6f;

constexpr size_t MiB = 1u << 20, KiB = 1024;
constexpr size_t WS_CTL = 0, CTL_ZERO_BYTES = 1 * MiB;
constexpr size_t WS_MOD = 1 * MiB;
constexpr size_t WS_CD = 1 * MiB + 128 * KiB;
constexpr size_t WS_VST = 1 * MiB + 256 * KiB;
constexpr size_t WS_DT = 2 * MiB;
constexpr size_t WS_LAC = 3 * MiB;
constexpr size_t WS_HALO = 4 * MiB;
constexpr size_t WS_WST = 5 * MiB + 512 * KiB;
constexpr size_t WS_WIN = 6 * MiB;
constexpr size_t WS_WOUT = 15 * MiB;
constexpr size_t WS_WQKV = 19 * MiB;
constexpr size_t WS_WO = 21 * MiB + 512 * KiB;
constexpr size_t WS_WGU = 23 * MiB + 512 * KiB;
constexpr size_t WS_WD = 45 * MiB + 512 * KiB;
constexpr size_t WS_XN = 57 * MiB;
constexpr size_t WS_ST = WS_XN;
constexpr size_t WS_PROJ = 89 * MiB;
constexpr size_t WS_H = WS_PROJ;
constexpr size_t WS_QKV = WS_PROJ;
constexpr size_t WS_AO = WS_PROJ + 40 * MiB;
constexpr size_t WS_CBG = 233 * MiB;
constexpr size_t WS_END = 249 * MiB;
constexpr int CW_BAR = 4096;
constexpr int XCD_BAR_WORDS_C = 3456;

#define RLX_AGENT __ATOMIC_RELAXED, __HIP_MEMORY_SCOPE_AGENT
#define LDS_WAIT() asm volatile("s_waitcnt lgkmcnt(0)" ::: "memory")
#define VM_WAIT() asm volatile("s_waitcnt vmcnt(0)" ::: "memory")
__host__ __device__ __forceinline__ unsigned f2bf(float f) { unsigned u = __builtin_bit_cast(unsigned, f); return (u + 0x7fffu + ((u >> 16) & 1u)) >> 16; }
__host__ __device__ __forceinline__ float bf2f(unsigned short h) { return __builtin_bit_cast(float, (unsigned)h << 16); }
__device__ __forceinline__ unsigned pk2(float lo, float hi) { return f2bf(lo) | (f2bf(hi) << 16); }
__device__ __forceinline__ float silu_f(float x) { return x / (1.0f + __expf(-x)); }
__device__ __forceinline__ float wave_sum(float v) {
#pragma unroll
    for (int o = 1; o < 64; o <<= 1) v += __shfl_xor(v, o);
    return v;
}

namespace pg8 {
#define PG8_LAS __attribute__((address_space(3)))
typedef unsigned short bf16_t;
typedef unsigned u32x4 __attribute__((ext_vector_type(4)));
constexpr int BM = 256, BK = 64, HALF = 128, HTB = HALF * BK * 2, STAGE_BYTES = 8 * HTB, NXCD = 8, WGM = 8;

__host__ __device__ __forceinline__ int lds_byte(int r, int c) { const int st = (r >> 4) * 2 + (c >> 5), rr = r & 15, cc = c & 31, ob = rr * 64 + cc * 2; return st * 1024 + (ob ^ (((ob >> 9) & 1) << 5)); }
__host__ __device__ __forceinline__ void stage_rc(int b, int& R, int& C) { const int st = b / 1024, sb = b % 1024, swz = sb ^ (((sb >> 9) & 1) << 5); R = (st >> 1) * 16 + swz / 64; C = (st & 1) * 32 + (swz % 64) / 2; }
__host__ __device__ __forceinline__ int perm32(int rho) { const int n = rho >> 4, i = rho & 15; return 8 * (i >> 2) + 4 * n + (i & 3); }

struct Unit { int pm, pn; };
struct Gemm { const bf16_t* A; const bf16_t* Bt; int M, N, K, lda; };

struct StaticOrder {
    int nM, nN, nwg, G, c;
    __host__ __device__ void init(int M, int N, int G_, int c_) { nM = M / BM; nN = N / BM; nwg = nM * nN; G = G_; c = c_; }
    __host__ __device__ bool next(int i, Unit& u) const {
        const long L = (long)i * G + c; if (L >= nwg) return false;
        int wgid = (int)L; { const int q = nwg / NXCD, r = nwg % NXCD, xcd = wgid % NXCD, off = wgid / NXCD; wgid = (xcd < r ? xcd * (q + 1) : r * (q + 1) + (xcd - r) * q) + off; }
        const int nig = WGM * nN, gid = wgid / nig, fm = gid * WGM, gsz = (nM - fm) < WGM ? (nM - fm) : WGM;
        u.pm = fm + ((wgid % nig) % gsz); u.pn = (wgid % nig) / gsz; return true;
    }
    __device__ __forceinline__ void a_ready(const Unit&) const {}
    __device__ __forceinline__ void done(const Unit&) const {}
};

typedef __bf16 bf16x2_t __attribute__((ext_vector_type(2)));
__device__ __forceinline__ unsigned cvt_pk_bf16(float lo, float hi) { f32x2 v = {lo, hi}; bf16x2_t b = __builtin_convertvector(v, bf16x2_t); return __builtin_bit_cast(unsigned, b); }
__device__ __forceinline__ f32x2 gelu_pk(f32x2 v) {
    const f32x2 av = __builtin_elementwise_abs(v), d = av * 0.2316418882f + 1.0f;
    f32x2 t; t.x = __builtin_amdgcn_rcpf(d.x); t.y = __builtin_amdgcn_rcpf(d.y);
    f32x2 q = t * 0.5307027145f + (-0.7265760135f); q = q * t + 0.7107068705f; q = q * t + (-0.142248368f); q = q * t + 0.127414796f; q = q * t;
    const f32x2 s = (v * v) * (-0.72134752044f);
    f32x2 e; e.x = __builtin_amdgcn_exp2f(s.x); e.y = __builtin_amdgcn_exp2f(s.y);
    const f32x2 m = v * (q * e), r = v - m;
    f32x2 o; o.x = v.x < 0.f ? m.x : r.x; o.y = v.y < 0.f ? m.y : r.y; return o;
}
__device__ __forceinline__ float silu1(float x) { return x * __builtin_amdgcn_rcpf(1.0f + __builtin_amdgcn_exp2f(-1.4426950408889634f * x)); }
__device__ __forceinline__ f32x4 silu4(f32x4 v) { f32x4 o; o[0] = silu1(v[0]); o[1] = silu1(v[1]); o[2] = silu1(v[2]); o[3] = silu1(v[3]); return o; }
__device__ __forceinline__ f32x4 gelu4(f32x4 v) { f32x2 a = gelu_pk((f32x2){v[0], v[1]}), b = gelu_pk((f32x2){v[2], v[3]}); return (f32x4){a.x, a.y, b.x, b.y}; }

struct EpiBf16 {
    static constexpr bool PERM = true, AFTER_DRAIN = false;
    bf16_t* O; int ldc; const float* bias;
    __device__ __forceinline__ void operator()(const f32x4 (&acc)[2][2][4][2], const Unit& u, int wr, int wc, int fr, int fq) const {
        const int row0 = u.pm * BM + wr * 64 + fr; const int col0 = u.pn * BM + wc * 32 + 8 * fq;
        f32x4 bv[2][2];
#pragma unroll
        for (int bj = 0; bj < 2; ++bj)
#pragma unroll
            for (int n = 0; n < 2; ++n) bv[bj][n] = bias ? *(const f32x4*)(bias + col0 + bj * HALF + 4 * n) : (f32x4){0.f, 0.f, 0.f, 0.f};
#pragma unroll
        for (int ai = 0; ai < 2; ++ai)
#pragma unroll
            for (int m = 0; m < 4; ++m) { bf16_t* rowp = O + (size_t)(row0 + ai * HALF + m * 16) * ldc + col0;
#pragma unroll
                for (int bj = 0; bj < 2; ++bj) { f32x4 v0 = acc[ai][bj][m][0] + bv[bj][0], v1 = acc[ai][bj][m][1] + bv[bj][1];
                    u32x4 w; w.x = cvt_pk_bf16(v0[0], v0[1]); w.y = cvt_pk_bf16(v0[2], v0[3]); w.z = cvt_pk_bf16(v1[0], v1[1]); w.w = cvt_pk_bf16(v1[2], v1[3]);
                    *(u32x4*)(rowp + bj * HALF) = w; } }
    }
};
struct EpiProj {
    static constexpr bool PERM = true, AFTER_DRAIN = false;
    bf16_t* O; bf16_t* halo;
    __device__ __forceinline__ void operator()(const f32x4 (&acc)[2][2][4][2], const Unit& u, int wr, int wc, int fr, int fq) const {
        const int row0 = u.pm * BM + wr * 64 + fr; const int col0 = u.pn * BM + wc * 32 + 8 * fq;
        const int act = (u.pn < 4) ? 1 : ((u.pn < 8 || u.pn >= 14) ? 2 : 0);
#pragma unroll
        for (int ai = 0; ai < 2; ++ai)
#pragma unroll
            for (int m = 0; m < 4; ++m) { const int row = row0 + ai * HALF + m * 16; bf16_t* rowp = O + (size_t)row * NPROJ + col0;
#pragma unroll
                for (int bj = 0; bj < 2; ++bj) { f32x4 v0 = acc[ai][bj][m][0], v1 = acc[ai][bj][m][1];
                    if (act == 1) { v0 = silu4(v0); v1 = silu4(v1); } else if (act == 2) { v0 = gelu4(v0); v1 = gelu4(v1); }
                    u32x4 w; w.x = cvt_pk_bf16(v0[0], v0[1]); w.y = cvt_pk_bf16(v0[2], v0[3]); w.z = cvt_pk_bf16(v1[0], v1[1]); w.w = cvt_pk_bf16(v1[2], v1[3]);
                    *(u32x4*)(rowp + bj * HALF) = w;
                    if (act == 0) { const int tl = row & 127; const int cn = ((row & (SEQ - 1)) >> 7) + 1;
                        if (tl >= 125 && cn < NCH) { const int b = row >> 13; const int ch = (u.pn - 8) * BM + wc * 32 + 8 * fq + bj * HALF;
                            *(u32x4*)(halo + ((size_t)((b * NCH + cn) * 3 + (tl - 125))) * CONVD + ch) = w; } } } }
    }
};
struct EpiRes {
    static constexpr bool PERM = false, AFTER_DRAIN = false;
    const float* base; float* out; const float* bias; const float* gate;
    __device__ __forceinline__ void operator()(const f32x4 (&acc)[2][2][4][2], const Unit& u, int wr, int wc, int fr, int fq) const {
        const int row0 = u.pm * BM + wr * 64 + fr, col0 = u.pn * BM + wc * 32 + 4 * fq; const int b = u.pm >> 5;
        f32x4 gv[2][2], bv[2][2];
#pragma unroll
        for (int bj = 0; bj < 2; ++bj)
#pragma unroll
            for (int n = 0; n < 2; ++n) { gv[bj][n] = *(const f32x4*)(gate + (size_t)b * 6144 + col0 + bj * HALF + n * 16);
                bv[bj][n] = bias ? *(const f32x4*)(bias + col0 + bj * HALF + n * 16) : (f32x4){0.f, 0.f, 0.f, 0.f}; }
#pragma unroll
        for (int ai = 0; ai < 2; ++ai)
#pragma unroll
            for (int m = 0; m < 4; ++m) { const size_t off = (size_t)(row0 + ai * HALF + m * 16) * DM + col0;
#pragma unroll
                for (int bj = 0; bj < 2; ++bj)
#pragma unroll
                    for (int n = 0; n < 2; ++n) { const f32x4 bs = *(const f32x4*)(base + off + bj * HALF + n * 16);
                        *(f32x4*)(out + off + bj * HALF + n * 16) = bs + gv[bj][n] * (acc[ai][bj][m][n] + bv[bj][n]); }
                if (m & 1) asm volatile("" ::: "memory"); }
    }
};
struct EpiSwiGLU {
    static constexpr bool PERM = true, AFTER_DRAIN = false;
    bf16_t* H;
    __device__ __forceinline__ void operator()(const f32x4 (&acc)[2][2][4][2], const Unit& u, int wr, int wc, int fr, int fq) const {
        const int row0 = u.pm * BM + wr * 64 + fr; const int col0 = u.pn * HALF + wc * 32 + 8 * fq;
#pragma unroll
        for (int ai = 0; ai < 2; ++ai)
#pragma unroll
            for (int m = 0; m < 4; ++m) { bf16_t* rowp = H + (size_t)(row0 + ai * HALF + m * 16) * FFN + col0;
                const f32x4 h0 = silu4(acc[ai][0][m][0]) * acc[ai][1][m][0], h1 = silu4(acc[ai][0][m][1]) * acc[ai][1][m][1];
                u32x4 w; w.x = cvt_pk_bf16(h0[0], h0[1]); w.y = cvt_pk_bf16(h0[2], h0[3]); w.z = cvt_pk_bf16(h1[0], h1[1]); w.w = cvt_pk_bf16(h1[2], h1[3]);
                *(u32x4*)rowp = w; }
    }
};

template <class Epi, class Sched, bool ALIGN_EPI = false, bool SP2 = false>
__device__ __forceinline__ void gemm_phase(PG8_LAS unsigned char* lds, const Gemm g, const Sched& S, const Epi& E) {
    const int tid = threadIdx.x, wid = __builtin_amdgcn_readfirstlane(tid >> 6), lane = tid & 63, wr = wid >> 2, wc = wid & 3, fr = lane & 15, fq = lane >> 4;
    const int K = g.K, nt = K / BK, lda = g.lda;
    unsigned voffA[2], voffB[2];
#pragma unroll
    for (int i = 0; i < 2; ++i) { int R, C; stage_rc(tid * 16 + i * 8192, R, C); const int Rb = Epi::PERM ? ((R & ~31) + perm32(R & 31)) : R;
        voffA[i] = (unsigned)(R * lda + C) * 2u; voffB[i] = (unsigned)(Rb * K + C) * 2u; }
    const size_t kstep = (size_t)(BK * 2);
    const size_t hstepA = (size_t)HALF * lda * 2, hstepB = (size_t)HALF * K * 2;
    const size_t tstepA = 2 * hstepA, tstepB = 2 * hstepB;
    const unsigned ldsw = (unsigned)wid * 1024u;
    const int aoff = lds_byte(wr * 64 + fr, fq * 8), boff = lds_byte(wc * 32 + fr, fq * 8);
#define PG8_SA(b, h) (((b) * 2 + (h)) * HTB)
#define PG8_SB(b, h) ((4 + (b) * 2 + (h)) * HTB)
#define PG8_STAGE(bufoff, gbase, voff) do { _Pragma("unroll") for (int _i = 0; _i < 2; ++_i) \
        __builtin_amdgcn_global_load_lds((const unsigned*)((const char*)(gbase) + (voff)[_i]), (PG8_LAS unsigned*)(lds + (bufoff) + ldsw + _i * 8192), 16, 0, 0); } while (0)
#define PG8_LDA(dst, b, h) do { _Pragma("unroll") for (int m = 0; m < 4; ++m) _Pragma("unroll") for (int k = 0; k < 2; ++k) dst[m][k] = *(const PG8_LAS bf16x8*)(lds + PG8_SA(b, h) + aoff + m * 2048 + k * 1024); } while (0)
#define PG8_LDB(dst, b, h) do { _Pragma("unroll") for (int n = 0; n < 2; ++n) _Pragma("unroll") for (int k = 0; k < 2; ++k) dst[n][k] = *(const PG8_LAS bf16x8*)(lds + PG8_SB(b, h) + boff + n * 2048 + k * 1024); } while (0)
#define PG8_MMA(ai, bj, At, Bt) do { __builtin_amdgcn_s_setprio(1); _Pragma("unroll") for (int m = 0; m < 4; ++m) _Pragma("unroll") for (int n = 0; n < 2; ++n) _Pragma("unroll") for (int k = 0; k < 2; ++k) \
        acc[ai][bj][m][n] = __builtin_amdgcn_mfma_f32_16x16x32_bf16(Bt[n][k], At[m][k], acc[ai][bj][m][n], 0, 0, 0); __builtin_amdgcn_s_setprio(0); } while (0)
#define PG8_WAIT_V(n) asm volatile("s_waitcnt vmcnt(" #n ")" ::: "memory")
#define PG8_WAIT_L(n) asm volatile("s_waitcnt lgkmcnt(" #n ")" ::: "memory")
#define PG8_BAR __builtin_amdgcn_s_barrier()
#define PG8_SCHED __builtin_amdgcn_sched_barrier(0)
    Unit cur, nxt; int ui = 0;
    if (!S.next(0, cur)) return;
    f32x4 acc[2][2][4][2];
#pragma unroll
    for (int a = 0; a < 2; ++a)
#pragma unroll
        for (int b = 0; b < 2; ++b)
#pragma unroll
            for (int m = 0; m < 4; ++m)
#pragma unroll
                for (int n = 0; n < 2; ++n) acc[a][b][m][n] = (f32x4){0.f, 0.f, 0.f, 0.f};
    bf16x8 At[4][2], B0[2][2], B1[2][2];
    const char* cA = (const char*)g.A + (size_t)cur.pm * tstepA; const char* cB = (const char*)g.Bt + (size_t)cur.pn * tstepB;
    S.a_ready(cur);
    if constexpr (SP2) {
        PG8_STAGE(PG8_SB(0, 0), cB, voffB); PG8_STAGE(PG8_SB(0, 1), cB + hstepB, voffB); PG8_STAGE(PG8_SA(0, 0), cA, voffA); PG8_STAGE(PG8_SA(0, 1), cA + hstepA, voffA);
        if (wr == 1) PG8_BAR;
        PG8_WAIT_V(2); PG8_BAR;
        PG8_STAGE(PG8_SB(1, 0), cB + kstep, voffB); PG8_STAGE(PG8_SA(1, 0), cA + kstep, voffA); PG8_STAGE(PG8_SB(1, 1), cB + hstepB + kstep, voffB);
        PG8_WAIT_V(6); PG8_BAR;
    } else {
        PG8_STAGE(PG8_SB(0, 0), cB, voffB); PG8_STAGE(PG8_SA(0, 0), cA, voffA); PG8_STAGE(PG8_SB(0, 1), cB + hstepB, voffB); PG8_STAGE(PG8_SA(0, 1), cA + hstepA, voffA);
        if (wr == 1) PG8_BAR;
        PG8_WAIT_V(4); PG8_BAR;
        PG8_STAGE(PG8_SB(1, 0), cB + kstep, voffB); PG8_STAGE(PG8_SA(1, 0), cA + kstep, voffA); PG8_STAGE(PG8_SB(1, 1), cB + hstepB + kstep, voffB);
        PG8_WAIT_V(6); PG8_BAR;
    }
    for (;;) {
        const bool has_next = S.next(ui + 1, nxt);
        const char* nA = has_next ? (const char*)g.A + (size_t)nxt.pm * tstepA : cA; const char* nB = has_next ? (const char*)g.Bt + (size_t)nxt.pn * tstepB : cB;
        for (int t = 0; t < nt; t += 2) {
            const bool last = (t == nt - 2);
            const char* a1 = cA + (size_t)(t + 1) * kstep;
            const char* a2 = last ? nA : cA + (size_t)(t + 2) * kstep; const char* b2 = last ? nB : cB + (size_t)(t + 2) * kstep;
            const char* a3 = a2 + kstep; const char* b3 = b2 + kstep;
            if (last && has_next) S.a_ready(nxt);
            if constexpr (SP2) {
            PG8_LDB(B0, 0, 0); PG8_LDB(B1, 0, 1); PG8_SCHED; PG8_LDA(At, 0, 0); PG8_STAGE(PG8_SA(1, 1), a1 + hstepA, voffA);
            PG8_WAIT_V(8); PG8_WAIT_L(0); PG8_BAR; PG8_MMA(0, 0, At, B0); PG8_MMA(0, 1, At, B1); PG8_BAR; PG8_SCHED;
            PG8_LDA(At, 0, 1); PG8_STAGE(PG8_SB(0, 0), b2, voffB); PG8_STAGE(PG8_SB(0, 1), b2 + hstepB, voffB); PG8_STAGE(PG8_SA(0, 0), a2, voffA);
            PG8_WAIT_V(8); PG8_WAIT_L(0); PG8_BAR; PG8_MMA(1, 0, At, B0); PG8_MMA(1, 1, At, B1); PG8_BAR; PG8_SCHED;
            PG8_LDB(B0, 1, 0); PG8_LDB(B1, 1, 1); PG8_SCHED; PG8_LDA(At, 1, 0); PG8_STAGE(PG8_SA(0, 1), a2 + hstepA, voffA);
            PG8_WAIT_V(8); PG8_WAIT_L(0); PG8_BAR; PG8_MMA(0, 0, At, B0); PG8_MMA(0, 1, At, B1); PG8_BAR; PG8_SCHED;
            PG8_LDA(At, 1, 1); PG8_STAGE(PG8_SB(1, 0), b3, voffB); PG8_STAGE(PG8_SB(1, 1), b3 + hstepB, voffB); PG8_STAGE(PG8_SA(1, 0), a3, voffA);
            PG8_WAIT_V(8); PG8_WAIT_L(0); PG8_BAR; PG8_MMA(1, 0, At, B0); PG8_MMA(1, 1, At, B1); PG8_BAR; PG8_SCHED;
            } else {
            PG8_LDB(B0, 0, 0); PG8_SCHED; PG8_LDA(At, 0, 0); PG8_STAGE(PG8_SA(1, 1), a1 + hstepA, voffA);
            PG8_WAIT_L(8); PG8_BAR; PG8_WAIT_L(0); PG8_MMA(0, 0, At, B0); PG8_BAR; PG8_SCHED;
            PG8_LDB(B1, 0, 1); PG8_STAGE(PG8_SB(0, 0), b2, voffB);
            PG8_BAR; PG8_WAIT_L(0); PG8_MMA(0, 1, At, B1); PG8_BAR;
            PG8_LDA(At, 0, 1); PG8_STAGE(PG8_SA(0, 0), a2, voffA);
            PG8_BAR; PG8_WAIT_L(0); PG8_MMA(1, 0, At, B0); PG8_BAR; PG8_SCHED;
            PG8_STAGE(PG8_SB(0, 1), b2 + hstepB, voffB);
            PG8_WAIT_V(6); PG8_BAR; PG8_MMA(1, 1, At, B1); PG8_BAR;
            PG8_LDB(B0, 1, 0); PG8_SCHED; PG8_LDA(At, 1, 0); PG8_STAGE(PG8_SA(0, 1), a2 + hstepA, voffA);
            PG8_WAIT_L(8); PG8_BAR; PG8_WAIT_L(0); PG8_MMA(0, 0, At, B0); PG8_BAR; PG8_SCHED;
            PG8_LDB(B1, 1, 1); PG8_STAGE(PG8_SB(1, 0), b3, voffB);
            PG8_BAR; PG8_WAIT_L(0); PG8_MMA(0, 1, At, B1); PG8_BAR;
            PG8_LDA(At, 1, 1); PG8_STAGE(PG8_SA(1, 0), a3, voffA);
            PG8_BAR; PG8_WAIT_L(0); PG8_MMA(1, 0, At, B0); PG8_BAR; PG8_SCHED;
            PG8_STAGE(PG8_SB(1, 1), b3 + hstepB, voffB);
            PG8_WAIT_V(6); PG8_BAR; PG8_MMA(1, 1, At, B1); PG8_BAR;
            }
        }
        if constexpr (ALIGN_EPI) { if (wr == 0) PG8_BAR; }
        if constexpr (!Epi::AFTER_DRAIN) { E(acc, cur, wr, wc, fr, fq); S.done(cur); }
        if (!has_next) break;
#pragma unroll
        for (int a = 0; a < 2; ++a)
#pragma unroll
            for (int b = 0; b < 2; ++b)
#pragma unroll
                for (int m = 0; m < 4; ++m)
#pragma unroll
                    for (int n = 0; n < 2; ++n) acc[a][b][m][n] = (f32x4){0.f, 0.f, 0.f, 0.f};
        cur = nxt; cA = nA; cB = nB; ++ui;
        if constexpr (ALIGN_EPI) { if (wr == 1) PG8_BAR; }
    }
    PG8_WAIT_V(0);
    if constexpr (!ALIGN_EPI) { if (wr == 0) PG8_BAR; }
    PG8_BAR;
#undef PG8_SA
#undef PG8_SB
#undef PG8_STAGE
#undef PG8_LDA
#undef PG8_LDB
#undef PG8_MMA
#undef PG8_WAIT_V
#undef PG8_WAIT_L
#undef PG8_BAR
#undef PG8_SCHED
}
}

#define XB_TMO      128
#define XB_XCNT(j)  (256  + 64 * (j))
#define XB_XSUB(j)  (1280 + 64 * (j))
#define XB_XGEN(j)  (2304 + 64 * (j))
#define XB_TOP      3328
#define XB_TOPGEN   3392
#define XCD_BAR_WORDS 3456
#define XB_SPIN_CAP (1u << 18)
__device__ __forceinline__ unsigned xb_ld(unsigned* p)              { return __hip_atomic_load(p, __ATOMIC_RELAXED, __HIP_MEMORY_SCOPE_AGENT); }
__device__ __forceinline__ unsigned xb_add(unsigned* p, unsigned v) { return __hip_atomic_fetch_add(p, v, __ATOMIC_RELAXED, __HIP_MEMORY_SCOPE_AGENT); }
__device__ __forceinline__ unsigned xb_xcc_id() { return (unsigned)__builtin_amdgcn_s_getreg((3 << 11) | 20) & 0xFu; }
#define XB_SPIN(cond, bar) do { unsigned _sp = 0; while (cond) { __builtin_amdgcn_s_sleep(1); \
    if ((++_sp & 255u) == 0u) { if (xb_ld(&(bar)[XB_TMO])) break; if (_sp > XB_SPIN_CAP) { atomicAdd(&(bar)[XB_TMO], 1u); break; } } } } while (0)
struct XcdBarrier { unsigned* bar; unsigned x; volatile LAS unsigned* st; };
__device__ __forceinline__ XcdBarrier xcd_barrier_post(unsigned* bar, volatile LAS unsigned* st) {
    XcdBarrier b; b.bar = bar; b.x = xb_xcc_id(); b.st = st;
    if (threadIdx.x == 0) (void)xb_add(&bar[XB_XCNT(b.x)], 1u);
    return b;
}
__device__ __forceinline__ void xcd_barrier_complete(unsigned* bar, unsigned x, unsigned& nloc, unsigned& nx) {
    const unsigned G = gridDim.x * gridDim.y * gridDim.z;
    unsigned sum, cnt, mine, sp = 0u;
    for (;;) {
        sum = 0u; cnt = 0u; mine = 0u;
#pragma unroll
        for (unsigned j = 0; j < 16; ++j) { const unsigned c = xb_ld(&bar[XB_XCNT(j)]); sum += c; cnt += (c > 0u) ? 1u : 0u; mine = (j == x) ? c : mine; }
        if (sum == G) break;
        __builtin_amdgcn_s_sleep(1);
        if ((++sp & 255u) == 0u) { if (xb_ld(&bar[XB_TMO])) break; if (sp > XB_SPIN_CAP) { atomicAdd(&bar[XB_TMO], 1u); break; } }
    }
    nloc = mine > 0u ? mine : 1u; nx = cnt > 0u ? cnt : 1u;
}
__device__ __forceinline__ void xcd_barrier(const XcdBarrier& b) {
    asm volatile("s_waitcnt vmcnt(0)" ::: "memory");
    __syncthreads();
    if (threadIdx.x == 0) {
        unsigned* bar = b.bar;
        __builtin_amdgcn_s_waitcnt(0);
        unsigned nloc = b.st[0], nx = b.st[1];
        if (nloc == 0u) { xcd_barrier_complete(bar, b.x, nloc, nx); b.st[0] = nloc; b.st[1] = nx; }
        const unsigned old = xb_add(&bar[XB_XSUB(b.x)], 1u);
        const unsigned gen = old / nloc;
        if (old + 1u == (gen + 1u) * nloc) {
            __builtin_amdgcn_fence(__ATOMIC_RELEASE, "agent");
            asm volatile("s_waitcnt vmcnt(0)" ::: "memory");
            const unsigned og = xb_add(&bar[XB_TOP], 1u);
            const unsigned tg = og / nx;
            if (og + 1u == (tg + 1u) * nx) xb_add(&bar[XB_TOPGEN], 1u);
            else XB_SPIN(xb_ld(&bar[XB_TOPGEN]) == tg, bar);
            __builtin_amdgcn_fence(__ATOMIC_ACQUIRE, "agent");
            xb_add(&bar[XB_XGEN(b.x)], 1u);
            asm volatile("s_waitcnt vmcnt(0)" ::: "memory");
        } else {
            XB_SPIN(xb_ld(&bar[XB_XGEN(b.x)]) == gen, bar);
            __builtin_amdgcn_fence(__ATOMIC_ACQUIRE, "agent");
            asm volatile("s_waitcnt vmcnt(0)" ::: "memory");
        }
    }
    __syncthreads();
}

constexpr int RING_OFF = 0, RING_BYTES = 131072;
constexpr int SCR_OFF = 147456;
constexpr int LDSCTL_OFF = 162816, MISC_OFF = LDSCTL_OFF + 320;
constexpr int LDS_BYTES = 163840;
constexpr int NWAVES = 8;

struct Args { const float* in[28]; float* out; unsigned char* ws; int ph_lo, ph_hi, li, pad; };

struct Frame {
    LAS unsigned char* lds;
    int tid, lane, wave, vcu, G;
};

__device__ __forceinline__ void tr_item(const float* W, int ldw, int K, int srccol, bf16* WT, int dstrow, int k0, LAS float* scr, int lane) {
#pragma unroll 8
    for (int i = 0; i < 32; ++i) { const int kk = 2 * i + (lane >> 5); scr[kk * 33 + (lane & 31)] = W[(size_t)(k0 + kk) * ldw + srccol + (lane & 31)]; }
    LDS_WAIT(); asm volatile("" ::: "memory");
    const int c = lane & 7;
#pragma unroll
    for (int j = 0; j < 4; ++j) { const int n = (lane >> 3) + 8 * j; const LAS float* s = scr + (8 * c) * 33 + n;
        v4u o; o.x = pk2(s[0 * 33], s[1 * 33]); o.y = pk2(s[2 * 33], s[3 * 33]); o.z = pk2(s[4 * 33], s[5 * 33]); o.w = pk2(s[6 * 33], s[7 * 33]);
        *(GAS v4u*)(WT + (size_t)(dstrow + n) * K + k0 + 8 * c) = o; }
    LDS_WAIT(); asm volatile("" ::: "memory");
}
struct TrSeg { const float* W; int ldw, K, srccol, N; bf16* WT; int dst0, mode; };
__device__ __forceinline__ void tr_seg_item(const TrSeg& s, int item, LAS float* scr, int lane) {
    const int nblk = s.N / 32, kb = item / nblk, nb = item % nblk, n0 = 32 * nb;
    int dstrow = s.dst0 + n0;
    if (s.mode) dstrow = 256 * (n0 >> 7) + (n0 & 127) + (s.mode == 2 ? 128 : 0);
    tr_item(s.W, s.ldw, s.K, s.srccol + n0, s.WT, dstrow, 64 * kb, scr, lane);
}
__device__ __forceinline__ void phase_prologue(const Frame& F, const Args& a) {
    unsigned char* ws = a.ws;
    if (blockIdx.x < 192) {
        const int cg = blockIdx.x, l = cg / 96, col = (cg % 96) * 64 + F.lane;
        const float* W = a.in[2] + (size_t)l * DM * 6144; const float* cv = a.in[1];
        float a0 = 0.f, a1 = 0.f;
        const int k0 = F.wave * 128;
#pragma unroll 4
        for (int k = k0; k < k0 + 128; ++k) { const float w = W[(size_t)k * 6144 + col]; a0 += silu_f(cv[k]) * w; a1 += silu_f(cv[DM + k]) * w; }
        LAS float* red = (LAS float*)(F.lds + SCR_OFF);
        red[(F.wave * 2 + 0) * 64 + F.lane] = a0; red[(F.wave * 2 + 1) * 64 + F.lane] = a1;
        __syncthreads();
        if (F.wave < 2) { float s = 0.f;
#pragma unroll
            for (int w = 0; w < 8; ++w) s += red[(w * 2 + F.wave) * 64 + F.lane];
            float* MOD = (float*)(ws + WS_MOD);
            MOD[((size_t)l * 2 + F.wave) * 6144 + col] = s + a.in[3][(size_t)l * 6144 + col]; }
        __syncthreads();
    }
    { bf16* WST = (bf16*)(ws + WS_WST); const float* wsrc = a.in[15];
      for (int i = blockIdx.x * 512 + F.tid; i < 8 * 128 * 128; i += F.G * 512) { const int t = (i >> 7) & 127, s = i & 127; WST[i] = (s <= t) ? (bf16)f2bf(wsrc[i]) : (bf16)0; } }
    LAS float* scr = (LAS float*)(F.lds + RING_OFF + F.wave * 16384);
    const int gw = F.vcu * NWAVES + F.wave, NGW = F.G * NWAVES;
    const float* in_w = a.in[6];
    int base = 0;
#define TR_SEG(Wp, ldw_, K_, srccol_, N_, WTp, dst0_, mode_) do { const TrSeg sg{(Wp), (ldw_), (K_), (srccol_), (N_), (WTp), (dst0_), (mode_)}; \
        const int cnt = ((K_) / 64) * ((N_) / 32); const int first = ((gw - base) % NGW + NGW) % NGW; \
        for (int j = first; j < cnt; j += NGW) tr_seg_item(sg, j, scr, F.lane); base += cnt; } while (0)
    TR_SEG(in_w, IN_EVEN, DM, 0, 1024, (bf16*)(ws + WS_WIN), 0, 0);
    TR_SEG(in_w, IN_EVEN, DM, 2576, 1024, (bf16*)(ws + WS_WIN), 1024, 0);
    TR_SEG(in_w, IN_EVEN, DM, 1024, 1536, (bf16*)(ws + WS_WIN), 2048, 0);
    TR_SEG(in_w, IN_EVEN, DM, 3600, 1024, (bf16*)(ws + WS_WIN), 3584, 0);
    TR_SEG(a.in[17], DM, 2048, 0, 1024, (bf16*)(ws + WS_WOUT), 0, 0);
    TR_SEG(a.in[18], QKVD, DM, 0, QKVD, (bf16*)(ws + WS_WQKV), 0, 0);
    TR_SEG(a.in[20], DM, DM, 0, DM, (bf16*)(ws + WS_WO), 0, 0);
    TR_SEG(a.in[24], FFN, DM, 0, FFN, (bf16*)(ws + WS_WGU), 0, 1);
    TR_SEG(a.in[25], FFN, DM, 0, FFN, (bf16*)(ws + WS_WGU), 0, 2);
    TR_SEG(a.in[24] + (size_t)DM * FFN, FFN, DM, 0, FFN, (bf16*)(ws + WS_WGU) + (size_t)NGU * DM, 0, 1);
    TR_SEG(a.in[25] + (size_t)DM * FFN, FFN, DM, 0, FFN, (bf16*)(ws + WS_WGU) + (size_t)NGU * DM, 0, 2);
    TR_SEG(a.in[26], DM, FFN, 0, DM, (bf16*)(ws + WS_WD), 0, 0);
    TR_SEG(a.in[26] + (size_t)FFN * DM, DM, FFN, 0, DM, (bf16*)(ws + WS_WD) + (size_t)DM * FFN, 0, 0);
#undef TR_SEG
}

template <int MODE>
__device__ __forceinline__ void phase_norm(const Frame& F, const float* xin, const float* w, const float* sh, const float* sc, bf16* xn, float* fout,
                                           const float* in_w, const float* dt_bias, float* DT) {
    LAS float* wdt = (LAS float*)(F.lds + RING_OFF);
    if constexpr (MODE == 1) {
        for (int i = F.tid; i < 16 * 1024; i += 512) { const int k = i >> 4, j = i & 15; wdt[j * 1024 + k] = in_w[(size_t)k * IN_EVEN + 2560 + j]; }
        __syncthreads();
    }
    const int gw = F.vcu * NWAVES + F.wave, NGW = F.G * NWAVES;
    const int lane = F.lane;
    for (int b = 0; b < BATCH; ++b) {
        f32x4 A[4], Bv[4];
#pragma unroll
        for (int j = 0; j < 4; ++j) { const int col = 4 * lane + 256 * j; const f32x4 wv = *(const f32x4*)(w + col);
            if constexpr (MODE == 2) { A[j] = wv; Bv[j] = (f32x4){0.f, 0.f, 0.f, 0.f}; }
            else { const f32x4 s = *(const f32x4*)(sc + (size_t)b * 6144 + col); A[j] = wv * (s + 1.0f); Bv[j] = *(const f32x4*)(sh + (size_t)b * 6144 + col); } }
        for (int m = b * SEQ + gw; m < (b + 1) * SEQ; m += NGW) {
            const GAS f32x4* xr = (const GAS f32x4*)(xin + (size_t)m * DM) + lane;
            f32x4 v[4]; float s = 0.f;
#pragma unroll
            for (int j = 0; j < 4; ++j) { v[j] = xr[64 * j]; s += (v[j].x * v[j].x + v[j].y * v[j].y) + (v[j].z * v[j].z + v[j].w * v[j].w); }
            const float rstd = 1.0f / sqrtf(wave_sum(s) * (1.0f / DM) + EPS);
#pragma unroll
            for (int j = 0; j < 4; ++j) v[j] = v[j] * rstd * A[j] + Bv[j];
            if constexpr (MODE == 2) {
                GAS f32x4* o = (GAS f32x4*)(fout + (size_t)m * DM) + lane;
#pragma unroll
                for (int j = 0; j < 4; ++j) o[64 * j] = v[j];
            } else {
                GAS unsigned long long* o8 = (GAS unsigned long long*)(xn + (size_t)m * DM) + lane;
#pragma unroll
                for (int j = 0; j < 4; ++j) o8[64 * j] = (unsigned long long)pk2(v[j].x, v[j].y) | ((unsigned long long)pk2(v[j].z, v[j].w) << 32);
            }
            if constexpr (MODE == 1) {
                float mine = 0.f;
#pragma unroll 1
                for (int jj = 0; jj < 16; ++jj) { float p = 0.f; asm volatile("" ::: "memory");
#pragma unroll
                    for (int j = 0; j < 4; ++j) { const f32x4 wv = *(const LAS f32x4*)(wdt + jj * 1024 + 4 * lane + 256 * j); p += (v[j].x * wv.x + v[j].y * wv.y) + (v[j].z * wv.z + v[j].w * wv.w); }
                    p = wave_sum(p); if (lane == jj) mine = p; }
                if (lane < 16) { const float xv = mine + dt_bias[lane]; DT[(size_t)m * 16 + lane] = xv > 20.f ? xv : log1pf(__expf(xv)); }
            }
        }
    }
}

__device__ __forceinline__ void phase_scan(const Frame& F, bf16* ST, const float* CD) {
    for (int idx = blockIdx.x * 512 + F.tid; idx < 2 * 16 * 64 * 64; idx += F.G * 512) {
        const int n2 = idx & 63, p = (idx >> 6) & 63, h = (idx >> 12) & 15, b = idx >> 16;
        float r0 = 0.f, r1 = 0.f;
#pragma unroll 4
        for (int c = 0; c < NCH; ++c) {
            const size_t off = ((size_t)((b * NCH + c) * NHEAD + h) * HDIM + p) * NSTATE + 2 * n2;
            const unsigned v = *(const unsigned*)(ST + off);
            *(unsigned*)(ST + off) = pk2(r0, r1);
            const float d = CD[(b * NCH + c) * NHEAD + h];
            r0 = r0 * d + bf2f((unsigned short)(v & 0xffffu)); r1 = r1 * d + bf2f((unsigned short)(v >> 16));
        }
    }
}

#ifndef MK_FAST_ATTN
#define MK_FAST_ATTN 1
#endif
#ifndef MK_FAST_GMLP
#define MK_FAST_GMLP 1
#endif
#ifndef MK_FAST_STATE
#define MK_FAST_STATE 1
#endif
#ifndef MK_FAST_OUT
#define MK_FAST_OUT 1
#endif
typedef short s16x4 __attribute__((ext_vector_type(4)));
#define MFMA32(a, b, c) __builtin_amdgcn_mfma_f32_32x32x16_bf16((a), (b), (c), 0, 0, 0)
__device__ __forceinline__ int crow(int i, int hh) { return (i & 3) + 8 * (i >> 2) + 4 * hh; }
__device__ __forceinline__ s16x4 lds_tr4(LAS const unsigned char* p) { return __builtin_bit_cast(s16x4, __builtin_amdgcn_ds_read_tr16_b64_v4i16((LAS s16x4*)p)); }
__device__ __forceinline__ bf16x8 tr_frag(LAS const unsigned char* p, int off2) { const s16x4 lo = lds_tr4(p), hi = lds_tr4(p + off2); return (bf16x8){lo[0], lo[1], lo[2], lo[3], hi[0], hi[1], hi[2], hi[3]}; }
__device__ __forceinline__ unsigned cvtpk(float lo, float hi) { return pg8::cvt_pk_bf16(lo, hi); }
#define PACK8(x, s2) __builtin_bit_cast(bf16x8, (v4u){cvtpk((x)[8 * (s2)], (x)[8 * (s2) + 1]), cvtpk((x)[8 * (s2) + 2], (x)[8 * (s2) + 3]), cvtpk((x)[8 * (s2) + 4], (x)[8 * (s2) + 5]), cvtpk((x)[8 * (s2) + 6], (x)[8 * (s2) + 7])})
__device__ __forceinline__ void unpack8(const v4u v, float (&f)[8]) {
    f[0] = __builtin_bit_cast(float, v.x << 16); f[1] = __builtin_bit_cast(float, v.x & 0xffff0000u); f[2] = __builtin_bit_cast(float, v.y << 16); f[3] = __builtin_bit_cast(float, v.y & 0xffff0000u);
    f[4] = __builtin_bit_cast(float, v.z << 16); f[5] = __builtin_bit_cast(float, v.z & 0xffff0000u); f[6] = __builtin_bit_cast(float, v.w << 16); f[7] = __builtin_bit_cast(float, v.w & 0xffff0000u);
}
__device__ __forceinline__ v4u pack8f(const float (&f)[8]) { return (v4u){cvtpk(f[0], f[1]), cvtpk(f[2], f[3]), cvtpk(f[4], f[5]), cvtpk(f[6], f[7])}; }
__device__ __forceinline__ float wave_scan_incl(float v, int lane) {
#pragma unroll
    for (int o = 1; o < 64; o <<= 1) { const float t = __shfl_up(v, o); if (lane >= o) v += t; }
    return v;
}

__device__ __forceinline__ void phase_attn(const Frame& F, const bf16* QKV, bf16* AO, const float* sinks, const float* table) {
    constexpr int KRS = 144, VRS = 192;
    LAS unsigned char* Kimg = F.lds;
    LAS unsigned char* Vimg = F.lds + 256 * KRS;
    LAS float* biasl = (LAS float*)(F.lds + SCR_OFF);
    LAS float* lsc = biasl + 1024;
    const int lane = F.lane, r = lane & 31, hh = lane >> 5, blk = (lane >> 4) & 1, q4 = (lane & 15) >> 2, p4 = lane & 3;
    for (int u = F.vcu; u < 256; u += F.G) {
        const int b = u >> 7, kvh = (u >> 6) & 1, nb = u & 63;
        const size_t m0 = (size_t)b * SEQ + (size_t)nb * 128;
        for (int i = F.tid; i < 8 * 128; i += 512) { const int rel = i & 127; int bucket = rel;
            if (rel >= 16) { const int lg = 16 + (int)(logf((float)rel * (1.0f / 16.0f)) / logf(8.0f) * 16.0f); bucket = lg < 31 ? lg : 31; }
            biasl[i] = table[bucket * 16 + kvh * 8 + (i >> 7)]; }
        for (int i = F.tid; i < 2048; i += 512) { const int row = i >> 3, ch = i & 7; v4u kv = {0u, 0u, 0u, 0u}, vv = {0u, 0u, 0u, 0u};
            if (nb > 0 || row >= 128) { const bf16* src = QKV + (m0 + row - 128) * QKVD + 1024 + kvh * 64 + ch * 8; kv = *(const v4u*)src; vv = *(const v4u*)(src + 128); }
            *(LAS v4u*)(Kimg + row * KRS + ch * 16) = kv; *(LAS v4u*)(Vimg + row * VRS + ch * 16) = vv; }
        __syncthreads();
        const int hd = kvh * 8 + F.wave; const float sink = sinks[hd];
        const LAS float* bl = biasl + F.wave * 128;
#pragma unroll 1
        for (int qt = 0; qt < 4; ++qt) {
            bf16x8 qf[4];
            { const bf16* qp = QKV + (m0 + 32 * qt + r) * QKVD + hd * 64 + 8 * hh;
#pragma unroll
              for (int ks = 0; ks < 4; ++ks) qf[ks] = *(const bf16x8*)(qp + 16 * ks); }
            f32x16 P[5];
#pragma unroll
            for (int j = 0; j < 5; ++j) { f32x16 a = {0.f, 0.f, 0.f, 0.f, 0.f, 0.f, 0.f, 0.f, 0.f, 0.f, 0.f, 0.f, 0.f, 0.f, 0.f, 0.f};
#pragma unroll
                for (int ks = 0; ks < 4; ++ks) { const bf16x8 kf = *(const LAS bf16x8*)(Kimg + (32 * (qt + j) + r) * KRS + (16 * ks + 8 * hh) * 2); a = MFMA32(kf, qf[ks], a); }
                P[j] = a; }
            float mx = sink;
#pragma unroll
            for (int j = 0; j < 5; ++j)
#pragma unroll
                for (int i = 0; i < 16; ++i) { const int sj = 32 * (qt + j) + crow(i, hh); const int rel = 32 * qt + r + 128 - sj;
                    const bool ok = (rel >= 0) && (rel < 128) && (nb > 0 || sj >= 128);
                    float sv = P[j][i] * 0.125f + bl[rel & 127]; sv = ok ? sv : -1e30f; P[j][i] = sv; mx = fmaxf(mx, sv); }
            mx = fmaxf(mx, __shfl_xor(mx, 32));
            float l = 0.f;
#pragma unroll
            for (int j = 0; j < 5; ++j)
#pragma unroll
                for (int i = 0; i < 16; ++i) { const float pe = __expf(P[j][i] - mx); P[j][i] = pe; l += pe; }
            l += __shfl_xor(l, 32); l += __expf(sink - mx);
            f32x16 O0 = {0.f, 0.f, 0.f, 0.f, 0.f, 0.f, 0.f, 0.f, 0.f, 0.f, 0.f, 0.f, 0.f, 0.f, 0.f, 0.f}, O1 = O0;
#pragma unroll
            for (int j = 0; j < 5; ++j)
#pragma unroll
                for (int s2 = 0; s2 < 2; ++s2) { const bf16x8 pa = PACK8(P[j], s2);
                    LAS const unsigned char* vp = Vimg + (32 * (qt + j) + 16 * s2 + 4 * hh + q4) * VRS + 32 * blk + 8 * p4;
                    const bf16x8 v0 = tr_frag(vp, 8 * VRS), v1 = tr_frag(vp + 64, 8 * VRS);
                    O0 = MFMA32(pa, v0, O0); O1 = MFMA32(pa, v1, O1); }
            if (hh == 0) lsc[F.wave * 32 + r] = l;
#pragma unroll
            for (int i = 0; i < 16; ++i) { const int qi = crow(i, hh); const float inv = 1.0f / lsc[F.wave * 32 + qi];
                bf16* op = AO + (m0 + 32 * qt + qi) * DM + hd * 64 + r;
                op[0] = (bf16)f2bf(O0[i] * inv); op[32] = (bf16)f2bf(O1[i] * inv); }
        }
        __syncthreads();
    }
}

__device__ __forceinline__ void gmlp_unit(const Frame& F, bf16* PROJ, int bc, int half, const bf16* WST, const float* bs, const float* lnw, const float* lnb) {
    constexpr int VRS = 320, GIMG = 128 * VRS;
    LAS float* stats = (LAS float*)(F.lds + SCR_OFF);
    LAS unsigned char* img = F.lds;
    int lane = F.lane; asm volatile("" : "+v"(lane));
    const int r = lane & 31, hh = lane >> 5, blk = (lane >> 4) & 1, q4 = (lane & 15) >> 2, p4 = lane & 3;
    for (int i = 0; i < 16; ++i) { const int t = 16 * F.wave + i; const bf16* vrow = PROJ + (size_t)(bc * CHUNK + t) * NPROJ + PJ_V;
        float f0[8], f1[8]; unpack8(*(const v4u*)(vrow + 8 * lane), f0); unpack8(*(const v4u*)(vrow + 512 + 8 * lane), f1);
        float sm = 0.f;
#pragma unroll
        for (int e = 0; e < 8; ++e) sm += f0[e] + f1[e];
        const float mean = wave_sum(sm) * (1.0f / 1024.0f); float qv = 0.f;
#pragma unroll
        for (int e = 0; e < 8; ++e) { const float d0 = f0[e] - mean, d1 = f1[e] - mean; qv += d0 * d0 + d1 * d1; }
        const float rstd = 1.0f / sqrtf(wave_sum(qv) * (1.0f / 1024.0f) + EPS);
        if (lane == 0) { stats[2 * t] = mean; stats[2 * t + 1] = rstd; } }
    __syncthreads();
    for (int pass = 0; pass < 2; ++pass) {
        for (int i = F.tid; i < 2 * 128 * 16; i += 512) { const int gi = i >> 11, sr = (i >> 4) & 127, ch = i & 15; const int col = (4 * half + 2 * pass + gi) * 128 + ch * 8;
            float f[8]; unpack8(*(const v4u*)(PROJ + (size_t)(bc * CHUNK + sr) * NPROJ + PJ_V + col), f);
            const float mu = stats[2 * sr], rs = stats[2 * sr + 1];
            const f32x4 w0 = *(const f32x4*)(lnw + col), w1 = *(const f32x4*)(lnw + col + 4), b0 = *(const f32x4*)(lnb + col), b1 = *(const f32x4*)(lnb + col + 4);
#pragma unroll
            for (int e = 0; e < 4; ++e) { f[e] = (f[e] - mu) * rs * w0[e] + b0[e]; f[4 + e] = (f[4 + e] - mu) * rs * w1[e] + b1[e]; }
            *(LAS v4u*)(img + gi * GIMG + sr * VRS + ch * 16) = pack8f(f); }
        __syncthreads();
        const int gi = F.wave >> 2, dt = F.wave & 3, g = 4 * half + 2 * pass + gi; const bf16* Wg = WST + (size_t)g * 128 * 128;
        f32x16 acc[4];
#pragma unroll
        for (int tt = 0; tt < 4; ++tt) acc[tt] = (f32x16){0.f, 0.f, 0.f, 0.f, 0.f, 0.f, 0.f, 0.f, 0.f, 0.f, 0.f, 0.f, 0.f, 0.f, 0.f, 0.f};
#pragma unroll
        for (int ks = 0; ks < 8; ++ks) { const bf16x8 bf = tr_frag(img + gi * GIMG + (16 * ks + 8 * hh + q4) * VRS + 64 * dt + 32 * blk + 8 * p4, 4 * VRS);
#pragma unroll
            for (int tt = 0; tt < 4; ++tt) { const bf16x8 af = *(const bf16x8*)(Wg + (32 * tt + r) * 128 + 16 * ks + 8 * hh); acc[tt] = MFMA32(af, bf, acc[tt]); } }
#pragma unroll
        for (int tt = 0; tt < 4; ++tt)
#pragma unroll
            for (int i = 0; i < 16; ++i) { const int t = 32 * tt + crow(i, hh); const float sv = acc[tt][i] + bs[g * CHUNK + t];
                bf16* up = PROJ + (size_t)(bc * CHUNK + t) * NPROJ + PJ_U + g * 128 + 32 * dt + r; *up = (bf16)f2bf(bf2f(*up) * sv); }
        __syncthreads();
    }
}

__device__ __forceinline__ void ssd_state_unit(const Frame& F, bf16* PROJ, const bf16* HALO, const float* DT, float* LAC, float* CD, bf16* ST,
                                               const float* conv_w, const float* conv_b, const float* a_log, int bc, int g) {
    constexpr int XRS = 1088, BRS = 320;
    LAS float* lacs = (LAS float*)(F.lds + SCR_OFF);
    LAS float* dtw = lacs + 1024;
    LAS unsigned char* xwimg = F.lds;
    LAS unsigned char* Bimg = F.lds + 64 * XRS;
    int lane = F.lane; asm volatile("" : "+v"(lane));
    const int r = lane & 31, hh = lane >> 5, blk = (lane >> 4) & 1, q4 = (lane & 15) >> 2, p4 = lane & 3;
    const int c = bc & (NCH - 1);
    { const int h = g * 8 + F.wave; const float a = -__expf(a_log[h]);
      const float d0 = DT[(size_t)(bc * CHUNK + lane) * 16 + h], d1 = DT[(size_t)(bc * CHUNK + 64 + lane) * 16 + h];
      float v0 = wave_scan_incl(d0 * a, lane); const float tot0 = __shfl(v0, 63);
      float v1 = wave_scan_incl(d1 * a, lane) + tot0; const float last = __shfl(v1, 63);
      LAC[(size_t)(bc * NHEAD + h) * CHUNK + lane] = v0; LAC[(size_t)(bc * NHEAD + h) * CHUNK + 64 + lane] = v1;
      lacs[F.wave * 128 + lane] = v0; lacs[F.wave * 128 + 64 + lane] = v1;
      dtw[F.wave * 128 + lane] = d0 * __expf(last - v0); dtw[F.wave * 128 + 64 + lane] = d1 * __expf(last - v1);
      if (lane == 0) CD[bc * NHEAD + h] = __expf(last); }
    int tidv = F.tid; asm volatile("" : "+v"(tidv));
    const bool active = tidv < 384; const int k = tidv % 96, sg = tidv / 96;
    const int col = k < 64 ? g * 512 + 8 * k : (k < 80 ? 1024 + g * 128 + 8 * (k - 64) : 1280 + g * 128 + 8 * (k - 80));
    bf16* pcol = PROJ + (size_t)bc * CHUNK * NPROJ + PJ_X + col;
    v4u hal[2][3];
    float cw[4][8], cbias[8];
    if (active) {
#pragma unroll
        for (int pass = 0; pass < 2; ++pass) { const int s0 = 16 * (4 * pass + sg);
#pragma unroll
            for (int j = 0; j < 3; ++j) { const int row = s0 - 3 + j; v4u hv = {0u, 0u, 0u, 0u};
                if (row >= 0) hv = *(const v4u*)(pcol + (size_t)row * NPROJ);
                else if (c > 0) hv = *(const v4u*)(HALO + ((size_t)bc * 3 + j) * CONVD + col);
                hal[pass][j] = hv; } }
#pragma unroll
        for (int j = 0; j < 4; ++j) { const f32x4 a0 = *(const f32x4*)(conv_w + j * CONVD + col), a1 = *(const f32x4*)(conv_w + j * CONVD + col + 4);
#pragma unroll
            for (int e = 0; e < 4; ++e) { cw[j][e] = a0[e]; cw[j][4 + e] = a1[e]; } }
        { const f32x4 a0 = *(const f32x4*)(conv_b + col), a1 = *(const f32x4*)(conv_b + col + 4);
#pragma unroll
          for (int e = 0; e < 4; ++e) { cbias[e] = a0[e]; cbias[4 + e] = a1[e]; } }
    }
    __syncthreads();
    f32x16 acc[2][4];
#pragma unroll
    for (int pt = 0; pt < 2; ++pt)
#pragma unroll
        for (int nt = 0; nt < 4; ++nt) acc[pt][nt] = (f32x16){0.f, 0.f, 0.f, 0.f, 0.f, 0.f, 0.f, 0.f, 0.f, 0.f, 0.f, 0.f, 0.f, 0.f, 0.f, 0.f};
#pragma unroll
    for (int pass = 0; pass < 2; ++pass) {
        if (active) { const int s0 = 16 * (4 * pass + sg);
            float x0[8], x1[8], x2[8];
            unpack8(hal[pass][0], x0); unpack8(hal[pass][1], x1); unpack8(hal[pass][2], x2);
#pragma unroll 2
            for (int tt = 0; tt < 16; ++tt) { const int t = s0 + tt; float x3[8], o[8];
                unpack8(*(const v4u*)(pcol + (size_t)t * NPROJ), x3);
#pragma unroll
                for (int e = 0; e < 8; ++e) { const float a = cbias[e] + cw[0][e] * x0[e] + cw[1][e] * x1[e] + cw[2][e] * x2[e] + cw[3][e] * x3[e]; o[e] = pg8::silu1(a); }
                const v4u ov = pack8f(o);
                *(v4u*)(pcol + (size_t)t * NPROJ) = ov;
                if (k < 64) { const float scv = dtw[(k >> 3) * 128 + t]; float os[8];
#pragma unroll
                    for (int e = 0; e < 8; ++e) os[e] = o[e] * scv;
                    *(LAS v4u*)(xwimg + (t - 64 * pass) * XRS + k * 16) = pack8f(os); }
                else if (k < 80) *(LAS v4u*)(Bimg + (t - 64 * pass) * BRS + (k - 64) * 16) = ov;
#pragma unroll
                for (int e = 0; e < 8; ++e) { x0[e] = x1[e]; x1[e] = x2[e]; x2[e] = x3[e]; } }
        }
        __syncthreads();
#pragma unroll
        for (int ks = 0; ks < 4; ++ks) { bf16x8 af[2], bfr[4];
#pragma unroll
            for (int pt = 0; pt < 2; ++pt) af[pt] = tr_frag(xwimg + (16 * ks + 8 * hh + q4) * XRS + (F.wave * 64 + 32 * pt) * 2 + 32 * blk + 8 * p4, 4 * XRS);
#pragma unroll
            for (int nt = 0; nt < 4; ++nt) bfr[nt] = tr_frag(Bimg + (16 * ks + 8 * hh + q4) * BRS + 64 * nt + 32 * blk + 8 * p4, 4 * BRS);
#pragma unroll
            for (int pt = 0; pt < 2; ++pt)
#pragma unroll
                for (int nt = 0; nt < 4; ++nt) acc[pt][nt] = MFMA32(af[pt], bfr[nt], acc[pt][nt]); }
        __syncthreads();
    }
    { const int h = g * 8 + F.wave; bf16* sp = ST + (size_t)(bc * NHEAD + h) * HDIM * NSTATE;
#pragma unroll
      for (int pt = 0; pt < 2; ++pt)
#pragma unroll
          for (int nt = 0; nt < 4; ++nt)
#pragma unroll
              for (int i = 0; i < 16; ++i) sp[(size_t)(32 * pt + crow(i, hh)) * NSTATE + 32 * nt + r] = (bf16)f2bf(acc[pt][nt][i]); }
}

__device__ __forceinline__ void ssd_out_unit(const Frame& F, bf16* PROJ, const float* DT, const float* LAC, const bf16* PREV, const float* d_skip, const float* norm_w, int bc, int g) {
    constexpr int BRS = 272, XRS = 1088, ZRS = 1040;
    LAS unsigned char* Bimg = F.lds;
    LAS unsigned char* Cimg = F.lds + 128 * BRS;
    LAS unsigned char* xsimg = F.lds + 2 * 128 * BRS;
    LAS unsigned char* zimg = F.lds;
    LAS float* lacs = (LAS float*)(F.lds + SCR_OFF);
    LAS float* dts = lacs + 1024;
    LAS float* ssq = lacs + 2048;
    int lane = F.lane; asm volatile("" : "+v"(lane));
    const int r = lane & 31, hh = lane >> 5, blk = (lane >> 4) & 1, q4 = (lane & 15) >> 2, p4 = lane & 3;
    const int j = F.wave, h = g * 8 + j;
    for (int i = F.tid; i < 1024; i += 512) { const int jj = i >> 7, l = i & 127; lacs[i] = LAC[(size_t)(bc * NHEAD + g * 8 + jj) * CHUNK + l]; dts[i] = DT[(size_t)(bc * CHUNK + l) * 16 + g * 8 + jj]; }
    for (int i = F.tid; i < 2 * 128 * 16; i += 512) { const int which = i >> 11, row = (i >> 4) & 127, ch = i & 15;
        const v4u v = *(const v4u*)(PROJ + (size_t)(bc * CHUNK + row) * NPROJ + (which ? PJ_C : PJ_B) + g * 128 + ch * 8);
        *(LAS v4u*)((which ? Cimg : Bimg) + row * BRS + ch * 16) = v; }
    for (int i = F.tid; i < 64 * 64; i += 512) { const int row = i >> 6, ch = i & 63;
        *(LAS v4u*)(xsimg + row * XRS + ch * 16) = *(const v4u*)(PROJ + (size_t)(bc * CHUNK + row) * NPROJ + PJ_X + g * 512 + ch * 8); }
    __syncthreads();
    const float Dh = d_skip[h];
    f32x16 acc[2][4];
#define DIAG_TILE(st, lt, half) do { asm volatile("" ::: "memory"); f32x16 X = {0.f, 0.f, 0.f, 0.f, 0.f, 0.f, 0.f, 0.f, 0.f, 0.f, 0.f, 0.f, 0.f, 0.f, 0.f, 0.f}; \
        _Pragma("unroll") for (int ks = 0; ks < 8; ++ks) { const bf16x8 bfr = *(const LAS bf16x8*)(Bimg + (32 * (st) + r) * BRS + (16 * ks + 8 * hh) * 2); X = MFMA32(bfr, cf[ks], X); } \
        const int l_ = 32 * (lt) + r; const float lacl = lacs[j * 128 + l_]; \
        _Pragma("unroll") for (int i = 0; i < 16; ++i) { const int s_ = 32 * (st) + crow(i, hh); float gv = X[i] * __expf(lacl - lacs[j * 128 + s_]) * dts[j * 128 + s_]; \
            gv = (s_ <= l_) ? gv : 0.f; gv = (s_ == l_) ? gv + Dh : gv; X[i] = gv; } \
        _Pragma("unroll") for (int s2 = 0; s2 < 2; ++s2) { const bf16x8 gf = PACK8(X, s2); \
            _Pragma("unroll") for (int pt = 0; pt < 2; ++pt) { const bf16x8 xf = tr_frag(xsimg + (32 * (st) + 16 * s2 - 64 * (half) + 4 * hh + q4) * XRS + (j * 64 + 32 * pt) * 2 + 32 * blk + 8 * p4, 8 * XRS); \
                acc[pt][lt] = MFMA32(xf, gf, acc[pt][lt]); } } __builtin_amdgcn_sched_barrier(0); } while (0)
#define LOAD_CF(lt) do { __builtin_amdgcn_sched_barrier(0); _Pragma("unroll") for (int ks = 0; ks < 8; ++ks) cf[ks] = *(const LAS bf16x8*)(Cimg + (32 * (lt) + r) * BRS + (16 * ks + 8 * hh) * 2); } while (0)
    {
        const bf16* pp = PREV + (size_t)(bc * NHEAD + h) * HDIM * NSTATE + (size_t)r * NSTATE + 8 * hh;
#pragma unroll
        for (int lt = 0; lt < 4; ++lt) { bf16x8 cf[8]; LOAD_CF(lt);
            const float el = __expf(lacs[j * 128 + 32 * lt + r]);
#pragma unroll
            for (int pt = 0; pt < 2; ++pt) { f32x16 a = {0.f, 0.f, 0.f, 0.f, 0.f, 0.f, 0.f, 0.f, 0.f, 0.f, 0.f, 0.f, 0.f, 0.f, 0.f, 0.f};
#pragma unroll
                for (int ks = 0; ks < 8; ++ks) { const bf16x8 pfr = *(const bf16x8*)(pp + (size_t)(32 * pt) * NSTATE + 16 * ks); a = MFMA32(pfr, cf[ks], a); }
                acc[pt][lt] = a * el; }
            __builtin_amdgcn_sched_barrier(0);
#pragma unroll 1
            for (int st = 0; st <= (lt < 1 ? lt : 1); ++st) DIAG_TILE(st, lt, 0);
        }
    }
    __syncthreads();
    for (int i = F.tid; i < 64 * 64; i += 512) { const int row = i >> 6, ch = i & 63;
        *(LAS v4u*)(xsimg + row * XRS + ch * 16) = *(const v4u*)(PROJ + (size_t)(bc * CHUNK + 64 + row) * NPROJ + PJ_X + g * 512 + ch * 8); }
    __syncthreads();
#pragma unroll
    for (int lt = 2; lt < 4; ++lt) { bf16x8 cf[8]; LOAD_CF(lt);
#pragma unroll 1
        for (int st = 2; st <= lt; ++st) DIAG_TILE(st, lt, 1);
    }
#undef DIAG_TILE
#undef LOAD_CF
    __syncthreads();
    for (int i = F.tid; i < 128 * 64; i += 512) { const int row = i >> 6, ch = i & 63;
        *(LAS v4u*)(zimg + row * ZRS + ch * 16) = *(const v4u*)(PROJ + (size_t)(bc * CHUNK + row) * NPROJ + PJ_Z + g * 512 + ch * 8); }
    __syncthreads();
    float ssl[4];
#pragma unroll
    for (int lt = 0; lt < 4; ++lt) { float ss = 0.f;
#pragma unroll
        for (int pt = 0; pt < 2; ++pt)
#pragma unroll
            for (int g4 = 0; g4 < 4; ++g4) { const v2u zz = *(const LAS v2u*)(zimg + (32 * lt + r) * ZRS + (j * 64 + 32 * pt + 8 * g4 + 4 * hh) * 2);
                const float z0 = __builtin_bit_cast(float, zz.x << 16), z1 = __builtin_bit_cast(float, zz.x & 0xffff0000u), z2 = __builtin_bit_cast(float, zz.y << 16), z3 = __builtin_bit_cast(float, zz.y & 0xffff0000u);
                float y0 = acc[pt][lt][4 * g4] * z0, y1 = acc[pt][lt][4 * g4 + 1] * z1, y2 = acc[pt][lt][4 * g4 + 2] * z2, y3 = acc[pt][lt][4 * g4 + 3] * z3;
                acc[pt][lt][4 * g4] = y0; acc[pt][lt][4 * g4 + 1] = y1; acc[pt][lt][4 * g4 + 2] = y2; acc[pt][lt][4 * g4 + 3] = y3;
                ss += (y0 * y0 + y1 * y1) + (y2 * y2 + y3 * y3); }
        ss += __shfl_xor(ss, 32); ssl[lt] = ss;
        if (hh == 0) ssq[j * 128 + 32 * lt + r] = ss; }
    __syncthreads();
#pragma unroll
    for (int lt = 0; lt < 4; ++lt) { float tot = 0.f;
#pragma unroll
        for (int jj = 0; jj < 8; ++jj) tot += ssq[jj * 128 + 32 * lt + r];
        const float rstd = 1.0f / sqrtf(tot * (1.0f / 512.0f) + EPS);
#pragma unroll
        for (int pt = 0; pt < 2; ++pt)
#pragma unroll
            for (int g4 = 0; g4 < 4; ++g4) { const int p0 = 32 * pt + 8 * g4 + 4 * hh; const f32x4 nw = *(const f32x4*)(norm_w + h * 64 + p0);
                v2u o; o.x = cvtpk(acc[pt][lt][4 * g4] * rstd * nw[0], acc[pt][lt][4 * g4 + 1] * rstd * nw[1]); o.y = cvtpk(acc[pt][lt][4 * g4 + 2] * rstd * nw[2], acc[pt][lt][4 * g4 + 3] * rstd * nw[3]);
                *(LAS v2u*)(zimg + (32 * lt + r) * ZRS + (j * 64 + p0) * 2) = o; } }
    (void)ssl;
    __syncthreads();
    for (int i = F.tid; i < 128 * 64; i += 512) { const int row = i >> 6, ch = i & 63;
        *(v4u*)(PROJ + (size_t)(bc * CHUNK + row) * NPROJ + PJ_Z + g * 512 + ch * 8) = *(const LAS v4u*)(zimg + row * ZRS + ch * 16); }
    __syncthreads();
}

enum { PH_PRO = 0, PH_NORM0, PH_INPROJ, PH_MIXA, PH_SCAN, PH_MIXC, PH_OUTPROJ, PH_NORM1, PH_UP0, PH_DOWN0, PH_NORM2, PH_QKV, PH_ATTN, PH_OPROJ, PH_NORM3, PH_UP1, PH_DOWN1, PH_FINAL, PH_COUNT };

__global__ void __launch_bounds__(NWAVES * 64, 2) mk_fwd(Args args) {
    extern __shared__ __attribute__((aligned(16))) unsigned char lds[];
    Frame F;
    F.lds = (LAS unsigned char*)lds;
    F.tid = threadIdx.x; F.lane = F.tid & 63; F.wave = __builtin_amdgcn_readfirstlane(F.tid >> 6);
    F.G = gridDim.x; { const int bx = blockIdx.x; F.vcu = (F.G % 8 == 0) ? (bx % 8) * (F.G / 8) + bx / 8 : bx; }
    unsigned char* ws = args.ws;
    gu32* ctl = (gu32*)(ws + WS_CTL);
    volatile LAS unsigned* MISC = (volatile LAS unsigned*)(F.lds + MISC_OFF);
    for (int u = F.tid; u < (LDS_BYTES - LDSCTL_OFF) / 4; u += NWAVES * 64) ((LAS unsigned*)(F.lds + LDSCTL_OFF))[u] = 0u;
    __syncthreads();
    const int lo = args.ph_lo, hi = args.ph_hi;
    XcdBarrier bar; bar.bar = (unsigned*)(ctl + CW_BAR) + args.li * XCD_BAR_WORDS; bar.x = 0; bar.st = nullptr;
    if (hi - lo > 1) bar = xcd_barrier_post((unsigned*)(ctl + CW_BAR) + args.li * XCD_BAR_WORDS, MISC + 8);
#define IN(k) (lo <= (k) && (k) < hi)
#define SEAM(k) do { if (IN(k) && IN((k) + 1)) xcd_barrier(bar); } while (0)

    float* MOD = (float*)(ws + WS_MOD);
    bf16* XN = (bf16*)(ws + WS_XN); bf16* PROJ = (bf16*)(ws + WS_PROJ); bf16* HB = (bf16*)(ws + WS_H);
    bf16* QKV = (bf16*)(ws + WS_QKV); bf16* AO = (bf16*)(ws + WS_AO);
    float* out = args.out;
    const float* MOD0 = MOD; const float* MOD1 = MOD + 2 * 6144;

    if (IN(PH_PRO)) { phase_prologue(F, args); } SEAM(PH_PRO);
    if (IN(PH_NORM0)) { phase_norm<1>(F, args.in[0], args.in[4], MOD0 + 0, MOD0 + 1024, XN, nullptr, args.in[6], args.in[9], (float*)(ws + WS_DT)); __syncthreads(); } SEAM(PH_NORM0);
    if (IN(PH_INPROJ)) {
        pg8::Gemm g{XN, (const bf16*)(ws + WS_WIN), MTOK, NPROJ, DM, DM}; pg8::StaticOrder S; S.init(MTOK, NPROJ, F.G, (int)blockIdx.x);
        pg8::EpiProj E{PROJ, (bf16*)(ws + WS_HALO)};
        pg8::gemm_phase<pg8::EpiProj, pg8::StaticOrder, true, true>(F.lds + RING_OFF, g, S, E);
    } SEAM(PH_INPROJ);
    if (IN(PH_MIXA)) {
#if MK_FAST_GMLP
        for (int u = F.vcu; u < 256; u += F.G) gmlp_unit(F, PROJ, u >> 1, u & 1, (const bf16*)(ws + WS_WST), args.in[16], args.in[13], args.in[14]);
#endif
#if MK_FAST_STATE
        for (int u = F.vcu; u < 256; u += F.G) ssd_state_unit(F, PROJ, (const bf16*)(ws + WS_HALO), (const float*)(ws + WS_DT), (float*)(ws + WS_LAC), (float*)(ws + WS_CD), (bf16*)(ws + WS_ST),
                                                              args.in[7], args.in[8], args.in[10], u >> 1, u & 1);
#endif
    } SEAM(PH_MIXA);
    if (IN(PH_SCAN)) { phase_scan(F, (bf16*)(ws + WS_ST), (const float*)(ws + WS_CD)); } SEAM(PH_SCAN);
    if (IN(PH_MIXC)) {
#if MK_FAST_OUT
        for (int u = F.vcu; u < 256; u += F.G) ssd_out_unit(F, PROJ, (const float*)(ws + WS_DT), (const float*)(ws + WS_LAC), (const bf16*)(ws + WS_ST), args.in[11], args.in[12], u >> 1, u & 1);
#endif
    } SEAM(PH_MIXC);
    if (IN(PH_OUTPROJ)) {
        pg8::Gemm g{PROJ, (const bf16*)(ws + WS_WOUT), MTOK, DM, 2048, NPROJ}; pg8::StaticOrder S; S.init(MTOK, DM, F.G, (int)blockIdx.x);
        pg8::EpiRes E{args.in[0], out, nullptr, MOD0 + 2048};
        pg8::gemm_phase<pg8::EpiRes, pg8::StaticOrder, true, true>(F.lds + RING_OFF, g, S, E);
    } SEAM(PH_OUTPROJ);
    if (IN(PH_NORM1)) { phase_norm<0>(F, out, args.in[5], MOD0 + 3072, MOD0 + 4096, XN, nullptr, nullptr, nullptr, nullptr); } SEAM(PH_NORM1);
    if (IN(PH_UP0)) {
        pg8::Gemm g{XN, (const bf16*)(ws + WS_WGU), MTOK, NGU, DM, DM}; pg8::StaticOrder S; S.init(MTOK, NGU, F.G, (int)blockIdx.x);
        pg8::EpiSwiGLU E{HB};
        pg8::gemm_phase<pg8::EpiSwiGLU, pg8::StaticOrder, true, true>(F.lds + RING_OFF, g, S, E);
    } SEAM(PH_UP0);
    if (IN(PH_DOWN0)) {
        pg8::Gemm g{HB, (const bf16*)(ws + WS_WD), MTOK, DM, FFN, FFN}; pg8::StaticOrder S; S.init(MTOK, DM, F.G, (int)blockIdx.x);
        pg8::EpiRes E{out, out, nullptr, MOD0 + 5120};
        pg8::gemm_phase<pg8::EpiRes, pg8::StaticOrder, true, true>(F.lds + RING_OFF, g, S, E);
    } SEAM(PH_DOWN0);
    if (IN(PH_NORM2)) { phase_norm<0>(F, out, args.in[4] + DM, MOD1 + 0, MOD1 + 1024, XN, nullptr, nullptr, nullptr, nullptr); } SEAM(PH_NORM2);
    if (IN(PH_QKV)) {
        pg8::Gemm g{XN, (const bf16*)(ws + WS_WQKV), MTOK, QKVD, DM, DM}; pg8::StaticOrder S; S.init(MTOK, QKVD, F.G, (int)blockIdx.x);
        pg8::EpiBf16 E{QKV, QKVD, args.in[19]};
        pg8::gemm_phase<pg8::EpiBf16, pg8::StaticOrder, true, true>(F.lds + RING_OFF, g, S, E);
    } SEAM(PH_QKV);
    if (IN(PH_ATTN)) {
#if MK_FAST_ATTN
        phase_attn(F, QKV, AO, args.in[22], args.in[23]);
#endif
    } SEAM(PH_ATTN);
    if (IN(PH_OPROJ)) {
        pg8::Gemm g{AO, (const bf16*)(ws + WS_WO), MTOK, DM, DM, DM}; pg8::StaticOrder S; S.init(MTOK, DM, F.G, (int)blockIdx.x);
        pg8::EpiRes E{out, out, args.in[21], MOD1 + 2048};
        pg8::gemm_phase<pg8::EpiRes, pg8::StaticOrder, true, true>(F.lds + RING_OFF, g, S, E);
    } SEAM(PH_OPROJ);
    if (IN(PH_NORM3)) { phase_norm<0>(F, out, args.in[5] + DM, MOD1 + 3072, MOD1 + 4096, XN, nullptr, nullptr, nullptr, nullptr); } SEAM(PH_NORM3);
    if (IN(PH_UP1)) {
        pg8::Gemm g{XN, (const bf16*)(ws + WS_WGU) + (size_t)NGU * DM, MTOK, NGU, DM, DM}; pg8::StaticOrder S; S.init(MTOK, NGU, F.G, (int)blockIdx.x);
        pg8::EpiSwiGLU E{HB};
        pg8::gemm_phase<pg8::EpiSwiGLU, pg8::StaticOrder, true, true>(F.lds + RING_OFF, g, S, E);
    } SEAM(PH_UP1);
    if (IN(PH_DOWN1)) {
        pg8::Gemm g{HB, (const bf16*)(ws + WS_WD) + (size_t)DM * FFN, MTOK, DM, FFN, FFN}; pg8::StaticOrder S; S.init(MTOK, DM, F.G, (int)blockIdx.x);
        pg8::EpiRes E{out, out, nullptr, MOD1 + 5120};
        pg8::gemm_phase<pg8::EpiRes, pg8::StaticOrder, true, true>(F.lds + RING_OFF, g, S, E);
    } SEAM(PH_DOWN1);
    if (IN(PH_FINAL)) { phase_norm<2>(F, out, args.in[27], nullptr, nullptr, nullptr, out, nullptr, nullptr, nullptr); }
#undef IN
#undef SEAM
}

__global__ void nv_conv(bf16* PROJ, const bf16* HALO, const float* conv_w, const float* conv_b) {
    const int bc = blockIdx.x / 6, ch = (blockIdx.x % 6) * 256 + threadIdx.x; const int c = bc % NCH;
    float r0 = 0.f, r1 = 0.f, r2 = 0.f;
    if (c > 0) { const bf16* hp = HALO + ((size_t)bc * 3) * CONVD + ch; r0 = bf2f(hp[0]); r1 = bf2f(hp[CONVD]); r2 = bf2f(hp[2 * CONVD]); }
    const float w0 = conv_w[ch], w1 = conv_w[CONVD + ch], w2 = conv_w[2 * CONVD + ch], w3 = conv_w[3 * CONVD + ch], cb = conv_b[ch];
    bf16* p = PROJ + (size_t)bc * CHUNK * NPROJ + PJ_X + ch;
    for (int t = 0; t < CHUNK; ++t) { const float r3 = bf2f(p[(size_t)t * NPROJ]); const float a = cb + w0 * r0 + w1 * r1 + w2 * r2 + w3 * r3;
        p[(size_t)t * NPROJ] = (bf16)f2bf(silu_f(a)); r0 = r1; r1 = r2; r2 = r3; }
}
__global__ void nv_cumsum(const float* DT, const float* a_log, float* LAC, float* CD) {
    const int idx = blockIdx.x * blockDim.x + threadIdx.x; if (idx >= BATCH * NCH * NHEAD) return;
    const int h = idx % NHEAD, bc = idx / NHEAD; const float a = -expf(a_log[h]); float run = 0.f;
    for (int l = 0; l < CHUNK; ++l) { run += DT[(size_t)(bc * CHUNK + l) * 16 + h] * a; LAC[(size_t)(bc * NHEAD + h) * CHUNK + l] = run; }
    CD[bc * NHEAD + h] = expf(run);
}
__global__ void __launch_bounds__(256) nv_states(const bf16* PROJ, const float* DT, const float* LAC, bf16* ST) {
    const int bch = blockIdx.x, h = bch % NHEAD, bc = bch / NHEAD, g = h / 8, tid = threadIdx.x;
    __shared__ float wgt[CHUNK]; __shared__ float xs_s[CHUNK][HDIM];
    const float* lacp = LAC + (size_t)(bc * NHEAD + h) * CHUNK; const float last = lacp[CHUNK - 1];
    for (int s = tid; s < CHUNK; s += 256) wgt[s] = DT[(size_t)(bc * CHUNK + s) * 16 + h] * expf(last - lacp[s]);
    __syncthreads();
    for (int i = tid; i < CHUNK * HDIM; i += 256) { const int s = i >> 6, p = i & 63; xs_s[s][p] = bf2f(PROJ[(size_t)(bc * CHUNK + s) * NPROJ + PJ_X + h * HDIM + p]) * wgt[s]; }
    __syncthreads();
    const int n = tid & 127, ph = tid >> 7;
    float acc[32];
#pragma unroll
    for (int j = 0; j < 32; ++j) acc[j] = 0.f;
    for (int s = 0; s < CHUNK; ++s) { const float bv = bf2f(PROJ[(size_t)(bc * CHUNK + s) * NPROJ + PJ_B + g * NSTATE + n]);
#pragma unroll
        for (int j = 0; j < 32; ++j) acc[j] += xs_s[s][ph * 32 + j] * bv; }
#pragma unroll
    for (int j = 0; j < 32; ++j) ST[((size_t)(bc * NHEAD + h) * HDIM + ph * 32 + j) * NSTATE + n] = (bf16)f2bf(acc[j]);
}
__global__ void __launch_bounds__(256) nv_cb(const bf16* PROJ, float* CBG) {
    const int bcg = blockIdx.x, g = bcg & 1, bc = bcg >> 1, tid = threadIdx.x;
    __shared__ float Bc[CHUNK][129]; __shared__ float Cc[CHUNK][129];
    for (int i = tid; i < CHUNK * NSTATE; i += 256) { const int s = i >> 7, n = i & 127; const bf16* row = PROJ + (size_t)(bc * CHUNK + s) * NPROJ;
        Bc[s][n] = bf2f(row[PJ_B + g * NSTATE + n]); Cc[s][n] = bf2f(row[PJ_C + g * NSTATE + n]); }
    __syncthreads();
    const int s = tid & 127, lh = tid >> 7;
    for (int l = lh * 64; l < lh * 64 + 64; ++l) { float a = 0.f;
        for (int n = 0; n < NSTATE; ++n) a += Cc[l][n] * Bc[s][n];
        CBG[((size_t)bcg * CHUNK + l) * CHUNK + s] = a; }
}
__global__ void __launch_bounds__(512) nv_ssd_out(bf16* PROJ, const float* DT, const float* LAC, const bf16* PREV, const float* CBG, const float* d_skip, const float* norm_w) {
    const int m = blockIdx.x >> 1, g = blockIdx.x & 1, tid = threadIdx.x, j = tid >> 6, p = tid & 63, h = g * 8 + j, l = m & 127, bc = m >> 7;
    __shared__ float cb_row[CHUNK], cvec[NSTATE], lac_s[8][CHUNK], dt_s[8][CHUNK], red[8];
    if (tid < 128) cb_row[tid] = CBG[((size_t)(bc * 2 + g) * CHUNK + l) * CHUNK + tid];
    else if (tid < 256) cvec[tid - 128] = bf2f(PROJ[(size_t)m * NPROJ + PJ_C + g * NSTATE + (tid - 128)]);
    for (int i = tid; i < 8 * CHUNK; i += 512) { const int jj = i >> 7, s = i & 127; lac_s[jj][s] = LAC[(size_t)(bc * NHEAD + g * 8 + jj) * CHUNK + s]; dt_s[jj][s] = DT[(size_t)(bc * CHUNK + s) * 16 + g * 8 + jj]; }
    __syncthreads();
    const float lacl = lac_s[j][l];
    float y = 0.f;
    for (int s = 0; s <= l; ++s) y += cb_row[s] * expf(lacl - lac_s[j][s]) * dt_s[j][s] * bf2f(PROJ[(size_t)(bc * CHUNK + s) * NPROJ + PJ_X + h * HDIM + p]);
    float yo = 0.f;
    const bf16* pv = PREV + ((size_t)(bc * NHEAD + h) * HDIM + p) * NSTATE;
    for (int n = 0; n < NSTATE; ++n) yo += cvec[n] * bf2f(pv[n]);
    y += yo * expf(lacl);
    y += d_skip[h] * bf2f(PROJ[(size_t)m * NPROJ + PJ_X + h * HDIM + p]);
    y *= bf2f(PROJ[(size_t)m * NPROJ + PJ_Z + h * HDIM + p]);
    float ss = wave_sum(y * y);
    if (p == 0) red[j] = ss;
    __syncthreads();
    float tot = 0.f;
#pragma unroll
    for (int q = 0; q < 8; ++q) tot += red[q];
    const float rstd = 1.0f / sqrtf(tot * (1.0f / 512.0f) + EPS);
    PROJ[(size_t)m * NPROJ + PJ_Z + h * HDIM + p] = (bf16)f2bf(y * rstd * norm_w[h * HDIM + p]);
}
__global__ void __launch_bounds__(256) nv_gmlp_stats(const bf16* PROJ, float* VST) {
    const int m = blockIdx.x * 4 + (threadIdx.x >> 6), lane = threadIdx.x & 63;
    const bf16* row = PROJ + (size_t)m * NPROJ + PJ_V;
    float v[16]; float s = 0.f;
#pragma unroll
    for (int i = 0; i < 16; ++i) { v[i] = bf2f(row[lane + 64 * i]); s += v[i]; }
    const float mean = wave_sum(s) * (1.0f / 1024.0f); float q = 0.f;
#pragma unroll
    for (int i = 0; i < 16; ++i) { const float d = v[i] - mean; q += d * d; }
    const float rstd = 1.0f / sqrtf(wave_sum(q) * (1.0f / 1024.0f) + EPS);
    if (lane == 0) { VST[2 * m] = mean; VST[2 * m + 1] = rstd; }
}
__global__ void __launch_bounds__(512) nv_gmlp_out(bf16* PROJ, const float* VST, const float* wsp, const float* bs, const float* lnw, const float* lnb) {
    const int m = blockIdx.x, t = m & 127, r0 = m - t, tid = threadIdx.x;
    __shared__ float mu[CHUNK], rs[CHUNK], wrow[8][CHUNK];
    if (tid < 128) { mu[tid] = VST[2 * (r0 + tid)]; rs[tid] = VST[2 * (r0 + tid) + 1]; }
    for (int i = tid; i < 8 * CHUNK; i += 512) { const int g = i >> 7, s = i & 127; wrow[g][s] = wsp[((size_t)g * CHUNK + t) * CHUNK + s]; }
    __syncthreads();
    for (int f = tid; f < 1024; f += 512) { const int g = f >> 7; const float lw = lnw[f], lb = lnb[f]; float sv = 0.f;
        for (int s = 0; s <= t; ++s) sv += wrow[g][s] * ((bf2f(PROJ[(size_t)(r0 + s) * NPROJ + PJ_V + f]) - mu[s]) * rs[s] * lw + lb);
        const float uu = bf2f(PROJ[(size_t)m * NPROJ + PJ_U + f]);
        PROJ[(size_t)m * NPROJ + PJ_U + f] = (bf16)f2bf(uu * (sv + bs[g * CHUNK + t])); }
}
__global__ void __launch_bounds__(64) nv_attn(const bf16* QKV, bf16* AO, const float* sinks, const float* table) {
    const int head = blockIdx.x & 15, m = (blockIdx.x >> 4) * 64 + threadIdx.x, t = m & (SEQ - 1), kvh = head >> 3;
    float q[64], o[64];
#pragma unroll
    for (int d = 0; d < 64; ++d) { q[d] = bf2f(QKV[(size_t)m * QKVD + head * 64 + d]); o[d] = 0.f; }
    float mrun = sinks[head], lsum = 1.0f;
    for (int j = 0; j < 128; ++j) { const int tk = t - 127 + j; if (tk < 0) continue; const int rel = 127 - j;
        const bf16* kr = QKV + (size_t)(m - rel) * QKVD + 1024 + kvh * 64; const bf16* vr = kr + 128;
        float s = 0.f;
#pragma unroll
        for (int d = 0; d < 64; ++d) s += q[d] * bf2f(kr[d]);
        int bucket = rel; if (rel >= 16) { int lg = 16 + (int)(logf((float)rel * (1.0f / 16.0f)) / logf(8.0f) * 16.0f); bucket = lg < 31 ? lg : 31; }
        s = s * 0.125f + table[bucket * 16 + head];
        const float mn = fmaxf(mrun, s), f = expf(mrun - mn), pp = expf(s - mn);
        lsum = lsum * f + pp;
#pragma unroll
        for (int d = 0; d < 64; ++d) o[d] = o[d] * f + pp * bf2f(vr[d]);
        mrun = mn; }
    const float inv = 1.0f / lsum;
#pragma unroll
    for (int d = 0; d < 64; ++d) AO[(size_t)m * DM + head * 64 + d] = (bf16)f2bf(o[d] * inv);
}

extern "C" void kernel_launch(void* const* d_in, const int* in_sizes, int n_in, void* d_out, int out_size, void* d_ws, size_t ws_size, hipStream_t stream) {
    static int grid = 0;
    if (grid == 0) {
        if (n_in != 28 || in_sizes[0] != MTOK * DM || out_size != MTOK * DM || ws_size < WS_END) { fprintf(stderr, "kernel_launch: unexpected shapes (n_in %d, in0 %d, out %d, ws %zu)\n", n_in, n_in > 0 ? in_sizes[0] : -1, out_size, ws_size); grid = -1; return; }
        int dev = 0, cus = 0;
        if (hipGetDevice(&dev) != hipSuccess || hipDeviceGetAttribute(&cus, hipDeviceAttributeMultiprocessorCount, dev) != hipSuccess) { grid = -1; return; }
        if (hipFuncSetAttribute((const void*)mk_fwd, hipFuncAttributeMaxDynamicSharedMemorySize, LDS_BYTES) != hipSuccess) { fprintf(stderr, "kernel_launch: hipFuncSetAttribute failed\n"); grid = -1; return; }
        (void)hipGetLastError();
        grid = cus;
    }
    if (grid < 0) return;
    (void)hipMemsetAsync((char*)d_ws + WS_CTL, 0, CTL_ZERO_BYTES, stream);
    Args a{};
    for (int i = 0; i < 28; ++i) a.in[i] = (const float*)d_in[i];
    a.out = (float*)d_out; a.ws = (unsigned char*)d_ws;
    unsigned char* ws = (unsigned char*)d_ws;
    int li = 0;
    auto launch = [&](int lo, int hi) { a.ph_lo = lo; a.ph_hi = hi; a.li = li++; hipLaunchKernelGGL(mk_fwd, dim3(grid), dim3(NWAVES * 64), LDS_BYTES, stream, a); };
    bf16* PROJ = (bf16*)(ws + WS_PROJ); float* DT = (float*)(ws + WS_DT); float* LAC = (float*)(ws + WS_LAC); float* CD = (float*)(ws + WS_CD);
    bf16* ST = (bf16*)(ws + WS_ST); float* CBG = (float*)(ws + WS_CBG); float* VST = (float*)(ws + WS_VST);
    (void)PROJ; (void)DT; (void)LAC; (void)CD; (void)ST; (void)CBG; (void)VST;
    int lo = -1;
    auto flush = [&](int hi) { if (lo >= 0 && hi > lo) launch(lo, hi); lo = -1; };
    for (int ph = 0; ph < PH_COUNT; ++ph) {
        bool pers = true, naive_after = false;
        if (ph == PH_MIXA) { pers = MK_FAST_GMLP || MK_FAST_STATE; naive_after = !(MK_FAST_GMLP && MK_FAST_STATE); }
        if (ph == PH_MIXC) { pers = MK_FAST_OUT; naive_after = !MK_FAST_OUT; }
        if (ph == PH_ATTN) { pers = MK_FAST_ATTN; naive_after = !MK_FAST_ATTN; }
        if (pers) { if (lo < 0) lo = ph; } else flush(ph);
        if (naive_after) {
            flush(ph + 1);
            if (ph == PH_MIXA) {
#if !MK_FAST_STATE
                hipLaunchKernelGGL(nv_conv, dim3(128 * 6), dim3(256), 0, stream, PROJ, (const bf16*)(ws + WS_HALO), a.in[7], a.in[8]);
                hipLaunchKernelGGL(nv_cumsum, dim3(8), dim3(256), 0, stream, DT, a.in[10], LAC, CD);
                hipLaunchKernelGGL(nv_states, dim3(2048), dim3(256), 0, stream, PROJ, DT, LAC, ST);
#endif
#if !MK_FAST_GMLP
                hipLaunchKernelGGL(nv_gmlp_stats, dim3(MTOK / 4), dim3(256), 0, stream, PROJ, VST);
                hipLaunchKernelGGL(nv_gmlp_out, dim3(MTOK), dim3(512), 0, stream, PROJ, VST, a.in[15], a.in[16], a.in[13], a.in[14]);
#endif
            }
            if (ph == PH_MIXC) {
                hipLaunchKernelGGL(nv_cb, dim3(256), dim3(256), 0, stream, PROJ, CBG);
                hipLaunchKernelGGL(nv_ssd_out, dim3(MTOK * 2), dim3(512), 0, stream, PROJ, DT, LAC, ST, CBG, a.in[11], a.in[12]);
            }
            if (ph == PH_ATTN) hipLaunchKernelGGL(nv_attn, dim3((MTOK / 64) * 16), dim3(64), 0, stream, (const bf16*)(ws + WS_QKV), (bf16*)(ws + WS_AO), a.in[22], a.in[23]);
        }
    }
    flush(PH_COUNT);
}
```
